# Optimizing an MI355X kernel written in HIP

```python
import jax
import jax.numpy as jnp
from jax import lax
import numpy as np


D_MODEL = 2048
BATCH = 8
SEQ = 4096
DEPTH = 2

GRID_W = 64
CTX_LEN = 256
NA_HEADS = 16
HEAD_DIM = 64
NA_WIDTH = NA_HEADS * HEAD_DIM
FOURIER_GROUPS = 8
FOURIER_GROUP_DIM = 128
FOURIER_WIDTH = FOURIER_GROUPS * FOURIER_GROUP_DIM
MIX_WIDTH = NA_WIDTH + FOURIER_WIDTH
PROJ_WIDTH = 3 * NA_WIDTH + FOURIER_WIDTH
WIN_ROWS_MAX = 8
WIN_COLS = 16
D_FF = 5632
CONV_WIDTH = 3
N_MOD = 6
EPS = 1e-6
ATTN_SCALE = HEAD_DIM ** -0.5

kernel_name = 'hybrid_natten_fnet_convffn_dit'


def rms_norm(x, g):
    xf = x.astype(jnp.float32)
    y = xf * lax.rsqrt(jnp.mean(xf * xf, axis=-1, keepdims=True) + EPS)
    return (y * g.astype(jnp.float32)).astype(x.dtype)


def adaln_mods(cond, w_ada, b_ada):
    m = jax.nn.silu(cond) @ w_ada + b_ada
    return [m[:, None, i * D_MODEL:(i + 1) * D_MODEL] for i in range(N_MOD)]


def modulate(h, shift, scale):
    return h * (1 + scale) + shift


def split_heads(t):
    return t.reshape(t.shape[0], t.shape[1], NA_HEADS, HEAD_DIM)


def context_attention(qc, kc, vc):
    s = jnp.einsum('bqhd,bkhd->bhqk', qc, kc).astype(jnp.float32) * ATTN_SCALE
    p = jax.nn.softmax(s, axis=-1).astype(vc.dtype)
    o = jnp.einsum('bhqk,bkhd->bqhd', p, vc)
    return o.reshape(o.shape[0], o.shape[1], NA_WIDTH)


def neighbourhood_attention(q, k, v, kc, vc, rpb):
    b, n = q.shape[0], q.shape[1]
    rows = n // GRID_W
    kr = min(WIN_ROWS_MAX, rows)
    n_loc = kr * WIN_COLS
    row_start = np.clip(np.arange(rows) - kr // 2, 0, rows - kr)
    col_start = np.clip(np.arange(GRID_W) - WIN_COLS // 2, 0, GRID_W - WIN_COLS)
    col_idx = col_start[:, None] + np.arange(WIN_COLS)[None, :]
    dr_idx = row_start[:, None] + np.arange(kr)[None, :] - np.arange(rows)[:, None] + WIN_ROWS_MAX - 1
    dc_idx = col_idx - np.arange(GRID_W)[:, None] + WIN_COLS - 1
    qg = q.reshape(b, rows, GRID_W, NA_HEADS, HEAD_DIM)
    kg = k.reshape(b, rows, GRID_W, NA_HEADS, HEAD_DIM)
    vg = v.reshape(b, rows, GRID_W, NA_HEADS, HEAD_DIM)

    def row_block(args):
        q_r, r0, dr = args
        k_win = lax.dynamic_slice_in_dim(kg, r0, kr, axis=1)[:, :, col_idx]
        v_win = lax.dynamic_slice_in_dim(vg, r0, kr, axis=1)[:, :, col_idx]
        bias = rpb[:, dr[None, :, None], dc_idx[:, None, :]].astype(jnp.float32)
        s_loc = jnp.einsum('bchd,brcjhd->bhcrj', q_r, k_win).astype(jnp.float32) * ATTN_SCALE + bias[None]
        s_ctx = jnp.einsum('bchd,bnhd->bhcn', q_r, kc).astype(jnp.float32) * ATTN_SCALE
        s = jnp.concatenate([s_loc.reshape(b, NA_HEADS, GRID_W, n_loc), s_ctx], axis=-1)
        p = jax.nn.softmax(s, axis=-1).astype(v.dtype)
        p_loc = p[..., :n_loc].reshape(b, NA_HEADS, GRID_W, kr, WIN_COLS)
        p_ctx = p[..., n_loc:]
        return (jnp.einsum('bhcrj,brcjhd->bchd', p_loc, v_win)
                + jnp.einsum('bhcn,bnhd->bchd', p_ctx, vc))

    out = lax.map(row_block, (jnp.moveaxis(qg, 1, 0),
                              jnp.asarray(row_start, dtype=jnp.int32),
                              jnp.asarray(dr_idx, dtype=jnp.int32)))
    return jnp.moveaxis(out, 0, 1).reshape(b, n, NA_WIDTH)


def fourier_mix(f, w_four):
    b, n = f.shape[0], f.shape[1]
    fg = f.reshape(b, n, FOURIER_GROUPS, FOURIER_GROUP_DIM).astype(jnp.float32)
    spec = jnp.fft.fftn(fg, axes=(1, 3), norm='ortho').real.astype(f.dtype)
    return jnp.einsum('bngc,gce->bnge', spec, w_four).reshape(b, n, FOURIER_WIDTH)


def conv_ffn(h, w_up, conv_w, conv_b, w_down):
    u = h @ w_up
    up = jnp.pad(u, ((0, 0), (1, 1), (0, 0)))
    u = up[:, :-2] * conv_w[0] + up[:, 1:-1] * conv_w[1] + up[:, 2:] * conv_w[2] + conv_b
    a, g = u[..., :D_FF], u[..., D_FF:]
    return (jax.nn.silu(g) * a) @ w_down


def setup_inputs(seed: int = 0) -> dict:
    key = jax.random.key(seed)
    ks = jax.random.split(key, 20)
    nrm = jax.random.normal
    f32 = jnp.float32
    return {
        'x': nrm(ks[0], (BATCH, SEQ, D_MODEL), f32),
        'c': nrm(ks[1], (BATCH, D_MODEL), f32),
        'ctx': nrm(ks[2], (BATCH, CTX_LEN, D_MODEL), f32),
        'c_ctx': nrm(ks[3], (D_MODEL,), f32),
        'w_ada': nrm(ks[4], (DEPTH, D_MODEL, N_MOD * D_MODEL), f32) * (0.5 * D_MODEL ** -0.5),
        'b_ada': nrm(ks[5], (DEPTH, N_MOD * D_MODEL), f32) * 0.01,
        'g_pre_mix': 1.0 + 0.05 * nrm(ks[6], (DEPTH, D_MODEL), f32),
        'w_in': nrm(ks[7], (DEPTH, D_MODEL, PROJ_WIDTH), f32) * D_MODEL ** -0.5,
        'rpb': nrm(ks[8], (DEPTH, NA_HEADS, 2 * WIN_ROWS_MAX - 1, 2 * WIN_COLS - 1), f32) * 0.1,
        'w_four': nrm(ks[9], (DEPTH, FOURIER_GROUPS, FOURIER_GROUP_DIM, FOURIER_GROUP_DIM), f32) * FOURIER_GROUP_DIM ** -0.5,
        'w_out': nrm(ks[10], (DEPTH, MIX_WIDTH, D_MODEL), f32) * MIX_WIDTH ** -0.5,
        'g_post_mix': 1.0 + 0.05 * nrm(ks[11], (DEPTH, D_MODEL), f32),
        'g_pre_ffn': 1.0 + 0.05 * nrm(ks[12], (DEPTH, D_MODEL), f32),
        'w_up': nrm(ks[13], (DEPTH, D_MODEL, 2 * D_FF), f32) * D_MODEL ** -0.5,
        'conv_w': nrm(ks[14], (DEPTH, CONV_WIDTH, 2 * D_FF), f32) * 0.5,
        'conv_b': nrm(ks[15], (DEPTH, 2 * D_FF), f32) * 0.01,
        'w_down': nrm(ks[16], (DEPTH, D_FF, D_MODEL), f32) * D_FF ** -0.5,
        'g_post_ffn': 1.0 + 0.05 * nrm(ks[17], (DEPTH, D_MODEL), f32),
    }


def reference(x, c, ctx, c_ctx, w_ada, b_ada, g_pre_mix, w_in, rpb, w_four, w_out,
              g_post_mix, g_pre_ffn, w_up, conv_w, conv_b, w_down, g_post_ffn):
    cx = ctx
    for l in range(DEPTH):
        last = l == DEPTH - 1
        sh_a, sc_a, gt_a, sh_f, sc_f, gt_f = adaln_mods(c, w_ada[l], b_ada[l])
        csh_a, csc_a, cgt_a, csh_f, csc_f, cgt_f = adaln_mods(c_ctx[None, :], w_ada[l], b_ada[l])

        h = modulate(rms_norm(x, g_pre_mix[l]), sh_a, sc_a)
        hc = modulate(rms_norm(cx, g_pre_mix[l]), csh_a, csc_a)
        proj = h @ w_in[l]
        q = split_heads(proj[..., :NA_WIDTH])
        k = split_heads(proj[..., NA_WIDTH:2 * NA_WIDTH])
        v = split_heads(proj[..., 2 * NA_WIDTH:3 * NA_WIDTH])
        f = proj[..., 3 * NA_WIDTH:]
        if last:
            kv_c = hc @ w_in[l][:, NA_WIDTH:3 * NA_WIDTH]
            kc = split_heads(kv_c[..., :NA_WIDTH])
            vc = split_heads(kv_c[..., NA_WIDTH:])
        else:
            proj_c = hc @ w_in[l]
            qc = split_heads(proj_c[..., :NA_WIDTH])
            kc = split_heads(proj_c[..., NA_WIDTH:2 * NA_WIDTH])
            vc = split_heads(proj_c[..., 2 * NA_WIDTH:3 * NA_WIDTH])
            fc = proj_c[..., 3 * NA_WIDTH:]

        attn = neighbourhood_attention(q, k, v, kc, vc, rpb[l])
        mix = jnp.concatenate([attn, fourier_mix(f, w_four[l])], axis=-1) @ w_out[l]
        x = x + gt_a * rms_norm(mix, g_post_mix[l])

        h = modulate(rms_norm(x, g_pre_ffn[l]), sh_f, sc_f)
        x = x + gt_f * rms_norm(conv_ffn(h, w_up[l], conv_w[l], conv_b[l], w_down[l]), g_post_ffn[l])

        if not last:
            mix_c = jnp.concatenate([context_attention(qc, kc, vc), fourier_mix(fc, w_four[l])], axis=-1) @ w_out[l]
            cx = cx + cgt_a * rms_norm(mix_c, g_post_mix[l])
            hc = modulate(rms_norm(cx, g_pre_ffn[l]), csh_f, csc_f)
            cx = cx + cgt_f * rms_norm(conv_ffn(hc, w_up[l], conv_w[l], conv_b[l], w_down[l]), g_post_ffn[l])
    return x
```

```cpp
#include <hip/hip_runtime.h>
#include <hip/hip_cooperative_groups.h>
#include <cstdio>
#include <cstdint>
#include <type_traits>
namespace cg = cooperative_groups;

#ifndef MK_MULTI
#define MK_MULTI 0
#endif

#ifndef G_SP2
#define G_SP2 1
#endif
#ifndef G_ALIGN
#define G_ALIGN 1
#endif
#ifndef PROBE_DUP
#define PROBE_DUP 0
#endif
#define LAS __attribute__((address_space(3)))
#define DI __device__ __forceinline__
typedef unsigned short bf16_t;
typedef short bf16x8 __attribute__((ext_vector_type(8)));
typedef float f32x2 __attribute__((ext_vector_type(2)));
typedef float f32x4 __attribute__((ext_vector_type(4)));
typedef float f32x16 __attribute__((ext_vector_type(16)));
typedef unsigned u32x2 __attribute__((ext_vector_type(2)));
typedef unsigned u32x4 __attribute__((ext_vector_type(4)));
typedef __bf16 bf16x2v __attribute__((ext_vector_type(2)));

DI unsigned pk2(float lo, float hi) { f32x2 v = {lo, hi}; return __builtin_bit_cast(unsigned, __builtin_convertvector(v, bf16x2v)); }
DI float bflo(unsigned u) { return __builtin_bit_cast(float, u << 16); }
DI float bfhi(unsigned u) { return __builtin_bit_cast(float, u & 0xffff0000u); }

constexpr int DM = 2048, NBATCH = 8, TL = 4096, TCX = 256;
constexpr int MLAT = NBATCH * TL, MCTX = NBATCH * TCX, MALL = MLAT + MCTX;
constexpr int NH = 16, DFF = 5632, DFF2 = 11264, NMODS = 12288;
constexpr int LPAD = TL + 2, CPAD = TCX + 2, CTXPB0 = NBATCH * LPAD;
constexpr int HROWS = CTXPB0 + NBATCH * CPAD + 64;
constexpr float EPS = 1e-6f, LOG2E = 1.4426950408889634f;
constexpr int NPH = 22;

constexpr size_t MiB = 1u << 20;
constexpr size_t WS_MODS = 0, WS_WCS = 1 * MiB, WS_DFT256 = 2 * MiB, WS_CX = 3 * MiB, WS_WIN = 19 * MiB, WS_WOUT = 51 * MiB,
                 WS_WUP = 67 * MiB, WS_WDN = 155 * MiB, WS_DFTN = 199 * MiB, WS_H = 263 * MiB, WS_PROJ = 400 * MiB,
                 WS_GT = 672 * MiB, WS_GTC = 800 * MiB, WS_MIXCAT = 808 * MiB, WS_RAW = 944 * MiB, WS_END = 992 * MiB;
constexpr size_t WS_QH = WS_PROJ, WS_KH = WS_PROJ + 68 * MiB, WS_VT = WS_PROJ + 136 * MiB, WS_F = WS_PROJ + 204 * MiB;
constexpr size_t WS_YP = WS_H;
constexpr size_t WS_MA = WS_DFT256 + 256 * 1024, WS_MB = WS_MA + 64 * 1024, WS_TW = WS_MB + 64 * 1024;
constexpr size_t WS_PART = WS_DFTN;
constexpr size_t WS_MIX = WS_PROJ;
constexpr size_t WS_ACT = WS_PROJ;
constexpr size_t WS_Y = WS_MIXCAT;
static_assert((size_t)HROWS * DM * 2 <= WS_PROJ - WS_H, "H");
static_assert((size_t)MALL * DFF * 2 <= WS_MIXCAT - WS_PROJ, "ACT");

constexpr int LDS_BYTES = 147456, LDS_MISC = 131072;
constexpr size_t WS_BAR = WS_MODS + 880 * 1024;

struct Args { const float* in[18]; float* out; unsigned char* ws; int ph_lo, ph_hi; };
#define CAS __attribute__((address_space(4)))
typedef const CAS Args& ArgsRef;
DI int tid_opaque() { int t = threadIdx.x; asm volatile("" : "+v"(t)); return t; }
enum { I_X = 0, I_C, I_CTX, I_CCTX, I_WADA, I_BADA, I_GPREMIX, I_WIN, I_RPB, I_WFOUR, I_WOUT, I_GPOSTMIX, I_GPREFFN, I_WUP, I_CONVW, I_CONVB, I_WDOWN, I_GPOSTFFN };

constexpr int BM = 256, BK = 64, HALF = 128, HTB = HALF * BK * 2, NXCD = 8, WGM = 8;
DI int lds_byte(int r, int c) { const int st = (r >> 4) * 2 + (c >> 5), rr = r & 15, cc = c & 31, ob = rr * 64 + cc * 2; return st * 1024 + (ob ^ (((ob >> 9) & 1) << 5)); }
DI void stage_rc(int b, int& R, int& C) { const int st = b / 1024, sb = b % 1024, swz = sb ^ (((sb >> 9) & 1) << 5); R = (st >> 1) * 16 + swz / 64; C = (st & 1) * 32 + (swz % 64) / 2; }
DI int perm32(int rho) { const int n = rho >> 4, i = rho & 15; return 8 * (i >> 2) + 4 * n + (i & 3); }

struct Unit { unsigned a0, a1, a2, a3, b; int pm, pn, z; };

DI long hpad_row(int g) { return g < MLAT ? (long)(g >> 12) * LPAD + 1 + (g & 4095) : (long)CTXPB0 + (long)CPAD * ((g - MLAT) >> 8) + 1 + ((g - MLAT) & 255); }
DI void strip_info(int sg, long& prow, int& seqrow0, int& T, int& k) {
    if (sg < 536) { const int seq = sg / 67; k = sg - 67 * seq; prow = (long)seq * LPAD + 62 * k; seqrow0 = seq * TL; T = TL; }
    else { const int s2 = sg - 536, seq = s2 / 5; k = s2 - 5 * seq; prow = (long)CTXPB0 + (long)CPAD * seq + 62 * k; seqrow0 = MLAT + seq * TCX; T = TCX; }
}

struct Sched {
    const char* base; unsigned A, B, sAz, sBz, kstepA, kstepB; int lda2, ldb2, nM, nN, nZ, mode, bmode, G, c;
    DI bool next(int i, Unit& u) const {
        const long L = (long)i * G + c; const int nMz = nM * nZ, nwg = nMz * nN; if (L >= nwg) return false;
        int wgid = (int)L; { const int q = nwg / NXCD, r = nwg % NXCD, xcd = wgid % NXCD, off = wgid / NXCD; wgid = (xcd < r ? xcd * (q + 1) : r * (q + 1) + (xcd - r) * q) + off; }
        const int nig = WGM * nN, gid = wgid / nig, fm = gid * WGM, gsz = (nMz - fm) < WGM ? (nMz - fm) : WGM;
        const int pmz = fm + ((wgid % nig) % gsz); u.pn = (wgid % nig) / gsz;
        const int z = pmz / nM, pm = pmz - z * nM; u.pm = pm; u.z = z;
        if (bmode == 0) u.b = B + (unsigned)z * sBz + (unsigned)u.pn * 256u * (unsigned)ldb2;
        else if (bmode == 1) u.b = B + (unsigned)z * sBz + (unsigned)((u.pn >> 4) * 4096 + 4 * (u.pn & 15)) * (unsigned)ldb2;
        else u.b = B + (unsigned)z * sBz + (unsigned)u.pn * 4u * 16384u;
        if (mode == 0) { const unsigned a = A + (unsigned)z * sAz + (unsigned)pm * 256u * (unsigned)lda2; u.a0 = a; u.a1 = a + 64u * lda2; u.a2 = a + 128u * lda2; u.a3 = a + 192u * lda2; }
        else if (mode == 1) { const int g = pm * 256; u.a0 = A + (unsigned)hpad_row(g) * lda2; u.a1 = A + (unsigned)hpad_row(g + 64) * lda2; u.a2 = A + (unsigned)hpad_row(g + 128) * lda2; u.a3 = A + (unsigned)hpad_row(g + 192) * lda2; }
        else { long p; int s0, T, k; strip_info(4 * pm, p, s0, T, k); u.a0 = A + (unsigned)p * lda2; strip_info(4 * pm + 1, p, s0, T, k); u.a1 = A + (unsigned)p * lda2;
               strip_info(4 * pm + 2, p, s0, T, k); u.a2 = A + (unsigned)p * lda2; strip_info(4 * pm + 3, p, s0, T, k); u.a3 = A + (unsigned)p * lda2; }
        return true;
    }
};

template <class Epi>
DI void gemm_phase(LAS unsigned char* lds, const Sched& S, const Epi& E, const int K) {
    const int tid = tid_opaque(), wid = __builtin_amdgcn_readfirstlane(tid >> 6), lane = tid & 63, wr = wid >> 2, wc = wid & 3, fr = lane & 15, fq = lane >> 4;
    const int nt = K / BK;
    unsigned voffA[2], voffB[2];
#pragma unroll
    for (int i = 0; i < 2; ++i) { int R, C; stage_rc(tid * 16 + i * 8192, R, C); const int Rb = (R & ~31) + perm32(R & 31);
        voffA[i] = (unsigned)((R & 63) * S.lda2 + C * 2);
        voffB[i] = S.bmode == 0 ? (unsigned)(Rb * S.ldb2 + C * 2) : S.bmode == 1 ? (unsigned)(((Rb >> 6) + 64 * (Rb & 63)) * S.ldb2 + C * 2) : (unsigned)((Rb >> 6) * 16384 + (Rb & 63) * 128 + C * 2); }
    const unsigned hstepB = S.bmode == 0 ? (unsigned)HALF * S.ldb2 : S.bmode == 1 ? 2u * S.ldb2 : 2u * 16384u;
    const unsigned kstepA = S.kstepA, kstepB = S.kstepB;
    const char* const gbase = S.base;
    const unsigned ldsw = (unsigned)wid * 1024u;
    const int aoff = lds_byte(wr * 64 + fr, fq * 8), boff = lds_byte(wc * 32 + fr, fq * 8);
#define G_SA(b, h) (((b) * 2 + (h)) * HTB)
#define G_SB(b, h) ((4 + (b) * 2 + (h)) * HTB)
#define G_STAGE_A(bufoff, p0, p1, koff) do { \
        __builtin_amdgcn_global_load_lds((const unsigned*)(gbase + (size_t)(unsigned)((p0) + (koff) + voffA[0])), (LAS unsigned*)(lds + (bufoff) + ldsw), 16, 0, 0); \
        __builtin_amdgcn_global_load_lds((const unsigned*)(gbase + (size_t)(unsigned)((p1) + (koff) + voffA[1])), (LAS unsigned*)(lds + (bufoff) + ldsw + 8192), 16, 0, 0); } while (0)
#define G_STAGE_B(bufoff, p, koff) do { \
        __builtin_amdgcn_global_load_lds((const unsigned*)(gbase + (size_t)(unsigned)((p) + (koff) + voffB[0])), (LAS unsigned*)(lds + (bufoff) + ldsw), 16, 0, 0); \
        __builtin_amdgcn_global_load_lds((const unsigned*)(gbase + (size_t)(unsigned)((p) + (koff) + voffB[1])), (LAS unsigned*)(lds + (bufoff) + ldsw + 8192), 16, 0, 0); } while (0)
#define G_LDA(dst, b, h) do { _Pragma("unroll") for (int m = 0; m < 4; ++m) _Pragma("unroll") for (int k = 0; k < 2; ++k) dst[m][k] = *(const LAS bf16x8*)(lds + G_SA(b, h) + aoff + m * 2048 + k * 1024); } while (0)
#define G_LDB(dst, b, h) do { _Pragma("unroll") for (int n = 0; n < 2; ++n) _Pragma("unroll") for (int k = 0; k < 2; ++k) dst[n][k] = *(const LAS bf16x8*)(lds + G_SB(b, h) + boff + n * 2048 + k * 1024); } while (0)
#define G_MMA(ai, bj, At, Bt) do { __builtin_amdgcn_s_setprio(1); _Pragma("unroll") for (int m = 0; m < 4; ++m) _Pragma("unroll") for (int n = 0; n < 2; ++n) _Pragma("unroll") for (int k = 0; k < 2; ++k) \
        acc[ai][bj][m][n] = __builtin_amdgcn_mfma_f32_16x16x32_bf16(Bt[n][k], At[m][k], acc[ai][bj][m][n], 0, 0, 0); __builtin_amdgcn_s_setprio(0); } while (0)
#define G_WAIT_V(n) asm volatile("s_waitcnt vmcnt(" #n ")" ::: "memory")
#define G_WAIT_L(n) asm volatile("s_waitcnt lgkmcnt(" #n ")" ::: "memory")
#define G_BAR __builtin_amdgcn_s_barrier()
#define G_SCHED __builtin_amdgcn_sched_barrier(0)
    Unit cur, nxt; int ui = 0;
    if (!S.next(0, cur)) return;
    f32x4 acc[2][2][4][2];
#pragma unroll
    for (int a = 0; a < 2; ++a)
#pragma unroll
        for (int b = 0; b < 2; ++b)
#pragma unroll
            for (int m = 0; m < 4; ++m)
#pragma unroll
                for (int n = 0; n < 2; ++n) acc[a][b][m][n] = (f32x4){0.f, 0.f, 0.f, 0.f};
    bf16x8 At[4][2], B0[2][2], B1[2][2];
#if G_SP2
    G_STAGE_B(G_SB(0, 0), cur.b, 0u); G_STAGE_B(G_SB(0, 1), cur.b + hstepB, 0u); G_STAGE_A(G_SA(0, 0), cur.a0, cur.a1, 0u); G_STAGE_A(G_SA(0, 1), cur.a2, cur.a3, 0u);
    if (wr == 1) G_BAR;
    G_WAIT_V(2); G_BAR;
#else
    G_STAGE_B(G_SB(0, 0), cur.b, 0u); G_STAGE_A(G_SA(0, 0), cur.a0, cur.a1, 0u); G_STAGE_B(G_SB(0, 1), cur.b + hstepB, 0u); G_STAGE_A(G_SA(0, 1), cur.a2, cur.a3, 0u);
    if (wr == 1) G_BAR;
    G_WAIT_V(4); G_BAR;
#endif
    G_STAGE_B(G_SB(1, 0), cur.b, kstepB); G_STAGE_A(G_SA(1, 0), cur.a0, cur.a1, kstepA); G_STAGE_B(G_SB(1, 1), cur.b + hstepB, kstepB);
    G_WAIT_V(6); G_BAR;
    for (;;) {
        const bool has_next = S.next(ui + 1, nxt);
        const unsigned n0 = has_next ? nxt.a0 : cur.a0, n1 = has_next ? nxt.a1 : cur.a1, n2 = has_next ? nxt.a2 : cur.a2, n3 = has_next ? nxt.a3 : cur.a3;
        const unsigned nB = has_next ? nxt.b : cur.b;
        for (int t = 0; t < nt; t += 2) {
            const bool last = (t == nt - 2);
            const unsigned k1 = (unsigned)(t + 1) * kstepA;
            const unsigned k2 = last ? 0u : (unsigned)(t + 2) * kstepA, k3 = k2 + kstepA;
            const unsigned kb2 = last ? 0u : (unsigned)(t + 2) * kstepB, kb3 = kb2 + kstepB;
            const unsigned x0 = last ? n0 : cur.a0, x1 = last ? n1 : cur.a1, x2 = last ? n2 : cur.a2, x3 = last ? n3 : cur.a3;
            const unsigned xb = last ? nB : cur.b;
#if G_SP2
            G_LDB(B0, 0, 0); G_LDB(B1, 0, 1); G_SCHED; G_LDA(At, 0, 0); G_STAGE_A(G_SA(1, 1), cur.a2, cur.a3, k1);
            G_WAIT_V(8); G_WAIT_L(0); G_BAR; G_MMA(0, 0, At, B0); G_MMA(0, 1, At, B1); G_BAR; G_SCHED;
            G_LDA(At, 0, 1); G_STAGE_B(G_SB(0, 0), xb, kb2); G_STAGE_B(G_SB(0, 1), xb + hstepB, kb2); G_STAGE_A(G_SA(0, 0), x0, x1, k2);
            G_WAIT_V(8); G_WAIT_L(0); G_BAR; G_MMA(1, 0, At, B0); G_MMA(1, 1, At, B1); G_BAR; G_SCHED;
            G_LDB(B0, 1, 0); G_LDB(B1, 1, 1); G_SCHED; G_LDA(At, 1, 0); G_STAGE_A(G_SA(0, 1), x2, x3, k2);
            G_WAIT_V(8); G_WAIT_L(0); G_BAR; G_MMA(0, 0, At, B0); G_MMA(0, 1, At, B1); G_BAR; G_SCHED;
            G_LDA(At, 1, 1); G_STAGE_B(G_SB(1, 0), xb, kb3); G_STAGE_B(G_SB(1, 1), xb + hstepB, kb3); G_STAGE_A(G_SA(1, 0), x0, x1, k3);
            G_WAIT_V(8); G_WAIT_L(0); G_BAR; G_MMA(1, 0, At, B0); G_MMA(1, 1, At, B1); G_BAR; G_SCHED;
#else
            G_LDB(B0, 0, 0); G_SCHED; G_LDA(At, 0, 0); G_STAGE_A(G_SA(1, 1), cur.a2, cur.a3, k1);
            G_WAIT_L(8); G_BAR; G_WAIT_L(0); G_MMA(0, 0, At, B0); G_BAR; G_SCHED;
            G_LDB(B1, 0, 1); G_STAGE_B(G_SB(0, 0), xb, kb2);
            G_BAR; G_WAIT_L(0); G_MMA(0, 1, At, B1); G_BAR;
            G_LDA(At, 0, 1); G_STAGE_A(G_SA(0, 0), x0, x1, k2);
            G_BAR; G_WAIT_L(0); G_MMA(1, 0, At, B0); G_BAR; G_SCHED;
            G_STAGE_B(G_SB(0, 1), xb + hstepB, kb2);
            G_WAIT_V(6); G_BAR; G_MMA(1, 1, At, B1); G_BAR;
            G_LDB(B0, 1, 0); G_SCHED; G_LDA(At, 1, 0); G_STAGE_A(G_SA(0, 1), x2, x3, k2);
            G_WAIT_L(8); G_BAR; G_WAIT_L(0); G_MMA(0, 0, At, B0); G_BAR; G_SCHED;
            G_LDB(B1, 1, 1); G_STAGE_B(G_SB(1, 0), xb, kb3);
            G_BAR; G_WAIT_L(0); G_MMA(0, 1, At, B1); G_BAR;
            G_LDA(At, 1, 1); G_STAGE_A(G_SA(1, 0), x0, x1, k3);
            G_BAR; G_WAIT_L(0); G_MMA(1, 0, At, B0); G_BAR; G_SCHED;
            G_STAGE_B(G_SB(1, 1), xb + hstepB, kb3);
            G_WAIT_V(6); G_BAR; G_MMA(1, 1, At, B1); G_BAR;
        #endif
        }
#if G_ALIGN
        if (wr == 0) G_BAR;
#endif
        E(acc, cur, wr, wc, fr, fq);
        if (!has_next) break;
#pragma unroll
        for (int a = 0; a < 2; ++a)
#pragma unroll
            for (int b = 0; b < 2; ++b)
#pragma unroll
                for (int m = 0; m < 4; ++m)
#pragma unroll
                    for (int n = 0; n < 2; ++n) acc[a][b][m][n] = (f32x4){0.f, 0.f, 0.f, 0.f};
        cur = nxt; ++ui;
#if G_ALIGN
        if (wr == 1) G_BAR;
#endif
    }
    G_WAIT_V(0);
#if !G_ALIGN
    if (wr == 0) G_BAR;
#endif
    G_BAR;
}

DI u32x4 pack8(const f32x4& v0, const f32x4& v1) { u32x4 w; w.x = pk2(v0[0], v0[1]); w.y = pk2(v0[2], v0[3]); w.z = pk2(v1[0], v1[1]); w.w = pk2(v1[2], v1[3]); return w; }

struct EpiPlain {
    bf16_t* C; int ldc;
    DI void operator()(const f32x4 (&acc)[2][2][4][2], const Unit& u, int wr, int wc, int fr, int fq) const {
        const int row0 = u.pm * 256 + wr * 64 + fr, col0 = u.pn * 256 + wc * 32 + 8 * fq;
#pragma unroll
        for (int ai = 0; ai < 2; ++ai)
#pragma unroll
            for (int m = 0; m < 4; ++m) { bf16_t* rowp = C + (size_t)(row0 + ai * 128 + m * 16) * ldc + col0;
#pragma unroll
                for (int bj = 0; bj < 2; ++bj) *(u32x4*)(rowp + bj * 128) = pack8(acc[ai][bj][m][0], acc[ai][bj][m][1]); }
    }
};

struct EpiF32Part {
    float* P;
    DI void operator()(const f32x4 (&acc)[2][2][4][2], const Unit& u, int wr, int wc, int fr, int fq) const {
        const int row0 = u.pm * 256 + wr * 64 + fr, col0 = u.pn * 256 + wc * 32 + 8 * fq;
        float* base = P + (size_t)u.z * MCTX * DM;
#pragma unroll
        for (int ai = 0; ai < 2; ++ai)
#pragma unroll
            for (int m = 0; m < 4; ++m) { float* rowp = base + (size_t)(row0 + ai * 128 + m * 16) * DM + col0;
#pragma unroll
                for (int bj = 0; bj < 2; ++bj) { *(f32x4*)(rowp + bj * 128) = acc[ai][bj][m][0]; *(f32x4*)(rowp + bj * 128 + 4) = acc[ai][bj][m][1]; } }
    }
};

struct EpiQKVF {
    bf16_t *QH, *KH, *VT, *F;
    DI void operator()(const f32x4 (&acc)[2][2][4][2], const Unit& u, int wr, int wc, int fr, int fq) const {
        const int kind = u.pn >> 2, sub = u.pn & 3;
        const int row0 = u.pm * 256 + wr * 64 + fr;
#pragma unroll
        for (int ai = 0; ai < 2; ++ai)
#pragma unroll
            for (int m = 0; m < 4; ++m) {
                const int row = row0 + ai * 128 + m * 16;
#pragma unroll
                for (int bj = 0; bj < 2; ++bj) {
                    const int cl = 128 * bj + 32 * wc + 8 * fq, head = sub * 4 + (cl >> 6), d0 = cl & 63;
                    const u32x4 w = pack8(acc[ai][bj][m][0], acc[ai][bj][m][1]);
                    if (kind == 0) *(u32x4*)(QH + ((size_t)head * MALL + row) * 64 + d0) = w;
                    else if (kind == 1) *(u32x4*)(KH + ((size_t)head * MALL + row) * 64 + d0) = w;
                    else if (kind == 3) *(u32x4*)(F + (size_t)row * 1024 + sub * 256 + cl) = w;
                    else { bf16_t* vp = VT + (size_t)(head * 64 + d0) * MALL + row;
                        vp[0] = (bf16_t)(w.x & 0xffffu); vp[(size_t)MALL] = (bf16_t)(w.x >> 16); vp[(size_t)2 * MALL] = (bf16_t)(w.y & 0xffffu); vp[(size_t)3 * MALL] = (bf16_t)(w.y >> 16);
                        vp[(size_t)4 * MALL] = (bf16_t)(w.z & 0xffffu); vp[(size_t)5 * MALL] = (bf16_t)(w.z >> 16); vp[(size_t)6 * MALL] = (bf16_t)(w.w & 0xffffu); vp[(size_t)7 * MALL] = (bf16_t)(w.w >> 16); }
                }
            }
    }
};

struct EpiGT {
    bf16_t *GT, *GTC; int ctx;
    DI void operator()(const f32x4 (&acc)[2][2][4][2], const Unit& u, int wr, int wc, int fr, int fq) const {
#pragma unroll
        for (int ai = 0; ai < 2; ++ai)
#pragma unroll
            for (int m = 0; m < 4; ++m) {
                const int e = wr * 64 + m * 16 + fr;
#pragma unroll
                for (int bj = 0; bj < 2; ++bj) {
                    const int cl = 128 * bj + 32 * wc + 8 * fq;
                    const u32x4 w = pack8(acc[ai][bj][m][0], acc[ai][bj][m][1]);
                    if (!ctx) { const int b = u.pn >> 4, n0 = (4 * (u.pn & 15) + (cl >> 6)) * 64 + (cl & 63); *(u32x4*)(GT + ((size_t)(b * 1024 + u.z * 128 + e)) * 8192 + ai * 4096 + n0) = w; }
                    else { const int b = u.pn; *(u32x4*)(GTC + ((size_t)(b * 1024 + u.z * 128 + e)) * 512 + ai * 256 + cl) = w; }
                }
            }
    }
};

struct EpiF2 {
    bf16_t* MIXCAT; float scale; int rowbase, rpz;
    DI void operator()(const f32x4 (&acc)[2][2][4][2], const Unit& u, int wr, int wc, int fr, int fq) const {
        const int row0 = rowbase + u.z * rpz + u.pm * 256 + wr * 64 + fr, col0 = 1024 + u.pn * 256 + wc * 32 + 8 * fq;
#pragma unroll
        for (int ai = 0; ai < 2; ++ai)
#pragma unroll
            for (int m = 0; m < 4; ++m) { bf16_t* rowp = MIXCAT + (size_t)(row0 + ai * 128 + m * 16) * DM + col0;
#pragma unroll
                for (int bj = 0; bj < 2; ++bj) *(u32x4*)(rowp + bj * 128) = pack8(acc[ai][bj][m][0] * scale, acc[ai][bj][m][1] * scale); }
    }
};

struct EpiStageA {
    bf16_t* YP; const float* TW;
    DI void operator()(const f32x4 (&acc)[2][2][4][2], const Unit& u, int wr, int wc, int fr, int fq) const {
        if (wr != 0) return;
#pragma unroll
        for (int m = 0; m < 4; ++m) {
            const int k1 = 16 * m + fr;
#pragma unroll
            for (int bj = 0; bj < 2; ++bj) {
                const int j0 = 128 * bj + 32 * wc + 8 * fq, ge = 4 * u.pn + (j0 >> 6), nl0 = j0 & 63;
                const f32x4* tw = (const f32x4*)(TW + (size_t)(k1 * 64 + nl0) * 2);
                f32x4 yr[2], yi[2];
#pragma unroll
                for (int n = 0; n < 2; ++n) {
                    const f32x4 t0 = tw[2 * n], t1 = tw[2 * n + 1];
                    const f32x4 c = {t0.x, t0.z, t1.x, t1.z}, s = {t0.y, t0.w, t1.y, t1.w};
                    const f32x4 r = acc[0][bj][m][n], i = acc[1][bj][m][n];
                    yr[n] = c * r + s * i; yi[n] = c * i - s * r;
                }
                bf16_t* dst = YP + ((((size_t)(u.z * 64 + k1)) * 1024 + ge) * 2) * 64 + nl0;
                *(u32x4*)dst = pack8(yr[0], yr[1]); *(u32x4*)(dst + 64) = pack8(yi[0], yi[1]);
            }
        }
    }
};
struct EpiStageB {
    bf16_t* MIXCAT;
    DI void operator()(const f32x4 (&acc)[2][2][4][2], const Unit& u, int wr, int wc, int fr, int fq) const {
        if (wr != 0) return;
        const int b = u.z >> 6, k1 = u.z & 63;
#pragma unroll
        for (int m = 0; m < 4; ++m) { const int k2 = 16 * m + fr; bf16_t* rowp = MIXCAT + (size_t)(b * 4096 + k1 + 64 * k2) * DM + 1024 + u.pn * 256 + wc * 32 + 8 * fq;
#pragma unroll
            for (int bj = 0; bj < 2; ++bj) *(u32x4*)(rowp + bj * 128) = pack8(acc[0][bj][m][0] * 0.015625f, acc[0][bj][m][1] * 0.015625f); }
    }
};

DI float dpp_ror1(float v) { return __builtin_bit_cast(float, __builtin_amdgcn_update_dpp(0, __builtin_bit_cast(int, v), 0x121, 0xF, 0xF, false)); }
DI float dpp_rol1(float v) { return __builtin_bit_cast(float, __builtin_amdgcn_update_dpp(0, __builtin_bit_cast(int, v), 0x12F, 0xF, 0xF, false)); }

struct EpiUpConv {
    bf16_t* ACT; bf16_t* RAW; const float* cw; const float* cb;
    DI void operator()(const f32x4 (&acc)[2][2][4][2], const Unit& u, int wr, int wc, int fr, int fq) const {
        const int colA = 128 * u.pn + 32 * wc + 8 * fq;
#pragma unroll
        for (int n = 0; n < 2; ++n) {
            const int ca = colA + 4 * n;
            const f32x4 wa0 = *(const f32x4*)(cw + ca), wa1 = *(const f32x4*)(cw + DFF2 + ca), wa2 = *(const f32x4*)(cw + 2 * DFF2 + ca), ba = *(const f32x4*)(cb + ca);
            const f32x4 wg0 = *(const f32x4*)(cw + DFF + ca), wg1 = *(const f32x4*)(cw + DFF2 + DFF + ca), wg2 = *(const f32x4*)(cw + 2 * DFF2 + DFF + ca), bg = *(const f32x4*)(cb + DFF + ca);
#pragma unroll
            for (int ai = 0; ai < 2; ++ai) {
                const int sg = 4 * u.pm + 2 * ai + wr, row0 = 64 * sg;
#pragma unroll
                for (int m = 0; m < 4; ++m) {
                    const int rho = 16 * m + fr;
                    const f32x4 ca_ = acc[ai][0][m][n], cg_ = acc[ai][1][m][n];
                    const f32x4 ua_ = acc[ai][0][m > 0 ? m - 1 : 0][n], ug_ = acc[ai][1][m > 0 ? m - 1 : 0][n];
                    const f32x4 da_ = acc[ai][0][m < 3 ? m + 1 : 3][n], dg_ = acc[ai][1][m < 3 ? m + 1 : 3][n];
                    float o[4];
#pragma unroll
                    for (int j = 0; j < 4; ++j) {
                        const float upa = dpp_ror1(fr == 15 ? ua_[j] : ca_[j]), dna = dpp_rol1(fr == 0 ? da_[j] : ca_[j]);
                        const float upg = dpp_ror1(fr == 15 ? ug_[j] : cg_[j]), dng = dpp_rol1(fr == 0 ? dg_[j] : cg_[j]);
                        const float va = wa0[j] * upa + wa1[j] * ca_[j] + wa2[j] * dna + ba[j];
                        const float vg = wg0[j] * upg + wg1[j] * cg_[j] + wg2[j] * dng + bg[j];
                        const float sgm = vg * __builtin_amdgcn_rcpf(1.f + __builtin_amdgcn_exp2f(-vg * LOG2E));
                        o[j] = sgm * va;
                    }
                    if (rho >= 1 && rho <= 62) { u32x2 w; w.x = pk2(o[0], o[1]); w.y = pk2(o[2], o[3]); *(u32x2*)(ACT + (size_t)(row0 + rho) * DFF + ca) = w; }
                    if (m == 0 || m == 3) {
                        if (rho <= 1 || rho >= 62) { const int slot = rho <= 1 ? rho : rho - 60;
                            bf16_t* rp = RAW + ((size_t)sg * 4 + slot) * DFF2 + ca;
                            u32x2 wa; wa.x = pk2(ca_[0], ca_[1]); wa.y = pk2(ca_[2], ca_[3]); *(u32x2*)rp = wa;
                            u32x2 wg; wg.x = pk2(cg_[0], cg_[1]); wg.y = pk2(cg_[2], cg_[3]); *(u32x2*)(rp + DFF) = wg; }
                    }
                }
            }
        }
    }
};
DI void up_fixup(ArgsRef a, int l) {
    const int tid = tid_opaque(), gtid = blockIdx.x * 512 + tid, NT = gridDim.x * 512;
    const bf16_t* RAW = (const bf16_t*)(a.ws + WS_RAW); bf16_t* ACT = (bf16_t*)(a.ws + WS_ACT);
    const float* cw = a.in[I_CONVW] + (size_t)l * 3 * DFF2; const float* cb = a.in[I_CONVB] + (size_t)l * DFF2;
    const int nstrips = l == 0 ? MALL / 64 : MLAT / 64;
    auto ld4 = [&](const bf16_t* p) -> f32x4 { const u32x2 w = *(const u32x2*)p; return (f32x4){bflo(w.x), bfhi(w.x), bflo(w.y), bfhi(w.y)}; };
    for (int it = gtid; it < nstrips * 2 * (DFF / 4); it += NT) {
        const int c4 = it % (DFF / 4), rw = it / (DFF / 4), sg = rw >> 1, last = rw & 1, ca = 4 * c4;
        const bool first_of_seq = sg < MLAT / 64 ? (sg & 63) == 0 : ((sg - MLAT / 64) & 3) == 0;
        const bool last_of_seq = sg < MLAT / 64 ? (sg & 63) == 63 : ((sg - MLAT / 64) & 3) == 3;
        const bf16_t* cur = RAW + ((size_t)sg * 4 + (last ? 3 : 0)) * DFF2 + ca;
        const bf16_t* up = last ? RAW + ((size_t)sg * 4 + 2) * DFF2 + ca : RAW + ((size_t)(sg - 1) * 4 + 3) * DFF2 + ca;
        const bf16_t* dn = last ? RAW + ((size_t)(sg + 1) * 4 + 0) * DFF2 + ca : RAW + ((size_t)sg * 4 + 1) * DFF2 + ca;
        const bool has_up = last || !first_of_seq, has_dn = !last || !last_of_seq;
        const f32x4 z = {0.f, 0.f, 0.f, 0.f};
        const f32x4 ca_ = ld4(cur), cg_ = ld4(cur + DFF);
        const f32x4 ua_ = has_up ? ld4(up) : z, ug_ = has_up ? ld4(up + DFF) : z;
        const f32x4 da_ = has_dn ? ld4(dn) : z, dg_ = has_dn ? ld4(dn + DFF) : z;
        const f32x4 wa0 = *(const f32x4*)(cw + ca), wa1 = *(const f32x4*)(cw + DFF2 + ca), wa2 = *(const f32x4*)(cw + 2 * DFF2 + ca), ba = *(const f32x4*)(cb + ca);
        const f32x4 wg0 = *(const f32x4*)(cw + DFF + ca), wg1 = *(const f32x4*)(cw + DFF2 + DFF + ca), wg2 = *(const f32x4*)(cw + 2 * DFF2 + DFF + ca), bg = *(const f32x4*)(cb + DFF + ca);
        const f32x4 va = wa0 * ua_ + wa1 * ca_ + wa2 * da_ + ba, vg = wg0 * ug_ + wg1 * cg_ + wg2 * dg_ + bg;
        float o[4];
#pragma unroll
        for (int j = 0; j < 4; ++j) o[j] = vg[j] * __builtin_amdgcn_rcpf(1.f + __builtin_amdgcn_exp2f(-vg[j] * LOG2E)) * va[j];
        u32x2 w; w.x = pk2(o[0], o[1]); w.y = pk2(o[2], o[3]);
        *(u32x2*)(ACT + (size_t)(64 * sg + (last ? 63 : 0)) * DFF + ca) = w;
    }
}

DI float wave_sum(float v) {
#pragma unroll
    for (int o = 1; o < 64; o <<= 1) v += __shfl_xor(v, o);
    return v;
}
#define LDS_WAIT() asm volatile("s_waitcnt lgkmcnt(0)" ::: "memory")

DI void p0_mods_item(LAS unsigned char* lds, ArgsRef a, float* MODS, int item) {
    const int tid = tid_opaque(), l = item / 96, chunk = item - 96 * l;
    LAS float* sc = (LAS float*)lds;
    const float* c = a.in[I_C]; const float* cctx = a.in[I_CCTX];
    for (int i = tid; i < 2048 * 9; i += 512) { const int k = i / 9, b = i - 9 * k; const float v = (b < 8) ? c[b * 2048 + k] : cctx[k]; sc[i] = v / (1.f + __expf(-v)); }
    __syncthreads();
    const int ks = tid >> 5, cgp = tid & 31, col = chunk * 128 + cgp * 4;
    const float* W = a.in[I_WADA] + (size_t)l * 2048 * NMODS + col;
    f32x4 acc[9];
#pragma unroll
    for (int b = 0; b < 9; ++b) acc[b] = (f32x4){0.f, 0.f, 0.f, 0.f};
#pragma unroll 4
    for (int k = ks * 128; k < ks * 128 + 128; ++k) {
        const f32x4 w = *(const f32x4*)(W + (size_t)k * NMODS);
#pragma unroll
        for (int b = 0; b < 9; ++b) acc[b] += sc[k * 9 + b] * w;
    }
    __syncthreads();
    LAS float* red = (LAS float*)lds;
#pragma unroll
    for (int b = 0; b < 9; ++b) *(LAS f32x4*)(red + (ks * 9 + b) * 128 + cgp * 4) = acc[b];
    __syncthreads();
    for (int o = tid; o < 9 * 128; o += 512) { const int b = o >> 7, cc = o & 127; float s = 0.f;
#pragma unroll
        for (int k2 = 0; k2 < 16; ++k2) s += red[(k2 * 9 + b) * 128 + cc];
        MODS[(size_t)(l * 9 + b) * NMODS + chunk * 128 + cc] = s + a.in[I_BADA][l * NMODS + chunk * 128 + cc]; }
    __syncthreads();
}
DI void p0_transpose_item(const float* W, int K, int N, bf16_t* WT, int up_map, LAS float* scr, int item, int lane) {
    const int nblk = N / 32, kb = item / nblk, nb = item - kb * nblk, k0 = 64 * kb, n0 = 32 * nb;
    int rowbase = n0;
    if (up_map) rowbase = (n0 < DFF) ? 256 * (n0 / 128) + (n0 % 128) : 256 * ((n0 - DFF) / 128) + 128 + ((n0 - DFF) % 128);
#pragma unroll 8
    for (int i = 0; i < 32; ++i) { const int kk = 2 * i + (lane >> 5); scr[kk * 33 + (lane & 31)] = W[(size_t)(k0 + kk) * N + n0 + (lane & 31)]; }
    LDS_WAIT(); asm volatile("" ::: "memory");
    const int c = lane & 7;
#pragma unroll
    for (int j = 0; j < 4; ++j) { const int n = (lane >> 3) + 8 * j; const LAS float* s = scr + (8 * c) * 33 + n;
        u32x4 o; o.x = pk2(s[0 * 33], s[1 * 33]); o.y = pk2(s[2 * 33], s[3 * 33]); o.z = pk2(s[4 * 33], s[5 * 33]); o.w = pk2(s[6 * 33], s[7 * 33]);
        *(u32x4*)(WT + (size_t)(rowbase + n) * K + k0 + 8 * c) = o; }
    LDS_WAIT(); asm volatile("" ::: "memory");
}
DI void p0_prologue(LAS unsigned char* lds, ArgsRef a) {
    const int tid = tid_opaque(), lane = tid & 63, wave = tid >> 6, G = gridDim.x, bx = blockIdx.x;
    unsigned char* ws = a.ws;
    __syncthreads();
    for (int item = bx; item < 192; item += G) p0_mods_item(lds, a, (float*)(ws + WS_MODS), item);
    LAS float* tab = (LAS float*)lds;
    __syncthreads();
    for (int p = tid; p < 4096; p += 512) tab[p] = cospif((float)p * (1.f / 2048.f));
    __syncthreads();
    const int gtid = bx * 512 + tid, NT = G * 512;
    {
        bf16_t* MA = (bf16_t*)(ws + WS_MA); bf16_t* MB = (bf16_t*)(ws + WS_MB); float* TW = (float*)(ws + WS_TW);
        for (int i = gtid; i < 256 * 128; i += NT) { const int r = i >> 7, col = i & 127, ri = r >> 7, rr = r & 127, cs = col >> 6, q = col & 63;
            float va = 0.f;
            if (rr < 64) { const int p = (rr * q * 64) & 4095; const float c = tab[p], s = tab[(p - 1024) & 4095]; va = ri == 0 ? (cs == 0 ? c : -s) : (cs == 0 ? -s : -c); }
            MA[i] = (bf16_t)(pk2(va, 0.f) & 0xffffu);
            float vb = 0.f;
            if (r < 64) { const int p = (r * q * 64) & 4095; vb = cs == 0 ? tab[p] : tab[(p - 1024) & 4095]; }
            MB[i] = (bf16_t)(pk2(vb, 0.f) & 0xffffu);
        }
        for (int i = gtid; i < 64 * 64; i += NT) { const int p = ((i >> 6) * (i & 63)) & 4095; TW[2 * i] = tab[p]; TW[2 * i + 1] = tab[(p - 1024) & 4095]; }
        bf16_t* D256 = (bf16_t*)(ws + WS_DFT256);
        for (int ch = gtid; ch < 256 * 64; ch += NT) { const int kp = ch >> 6, j0 = (ch & 63) * 8, cs = j0 >> 8, n0 = j0 & 255;
            float v[8];
#pragma unroll
            for (int e = 0; e < 8; ++e) v[e] = tab[((((kp * (n0 + e)) & 255) << 4) + cs * 1024) & 4095];
            u32x4 o; o.x = pk2(v[0], v[1]); o.y = pk2(v[2], v[3]); o.z = pk2(v[4], v[5]); o.w = pk2(v[6], v[7]);
            *(u32x4*)(D256 + (size_t)ch * 8) = o; }
        bf16_t* WCS = (bf16_t*)(ws + WS_WCS);
        for (int ch = gtid; ch < 65536; ch += NT) { const int c0 = (ch & 15) * 8, r = (ch >> 4) & 255, cs = r >> 7, e = r & 127, lg = ch >> 12;
            const float* wf = a.in[I_WFOUR] + (size_t)lg * 128 * 128 + e;
            float v[8];
#pragma unroll
            for (int q = 0; q < 8; ++q) v[q] = 0.f;
            for (int m = 0; m < 128; ++m) { const float w = wf[m * 128];
#pragma unroll
                for (int q = 0; q < 8; ++q) v[q] += w * tab[((((m * (c0 + q)) & 127) << 5) - cs * 1024) & 4095]; }
            const float sc = 0.08838834764831845f;
            u32x4 o; o.x = pk2(v[0] * sc, v[1] * sc); o.y = pk2(v[2] * sc, v[3] * sc); o.z = pk2(v[4] * sc, v[5] * sc); o.w = pk2(v[6] * sc, v[7] * sc);
            *(u32x4*)(WCS + (size_t)ch * 8) = o; }
        bf16_t* H = (bf16_t*)(ws + WS_H);
        for (int i = gtid; i < 32 * 256; i += NT) { const int rr = i >> 8, cc = (i & 255) * 8, seq = rr >> 1, hi = rr & 1;
            const long prow = seq < 8 ? (long)seq * LPAD + (hi ? LPAD - 1 : 0) : (long)CTXPB0 + (long)(seq - 8) * CPAD + (hi ? CPAD - 1 : 0);
            *(u32x4*)(H + prow * DM + cc) = (u32x4){0u, 0u, 0u, 0u}; }
    }
    __syncthreads();
    LAS float* scr = (LAS float*)(lds + wave * 16384);
    const int gw = bx * 8 + wave, NGW = G * 8;
    for (int it = gw; it < 2 * 23040; it += NGW) {
        const int l = it / 23040; int r = it - l * 23040;
        if (r < 4096) { p0_transpose_item(a.in[I_WIN] + (size_t)l * 2048 * 4096, 2048, 4096, (bf16_t*)(ws + WS_WIN) + (size_t)l * 4096 * 2048, 0, scr, r, lane); continue; } r -= 4096;
        if (r < 2048) { p0_transpose_item(a.in[I_WOUT] + (size_t)l * 2048 * 2048, 2048, 2048, (bf16_t*)(ws + WS_WOUT) + (size_t)l * 2048 * 2048, 0, scr, r, lane); continue; } r -= 2048;
        if (r < 11264) { p0_transpose_item(a.in[I_WUP] + (size_t)l * 2048 * DFF2, 2048, DFF2, (bf16_t*)(ws + WS_WUP) + (size_t)l * DFF2 * 2048, 1, scr, r, lane); continue; } r -= 11264;
        p0_transpose_item(a.in[I_WDOWN] + (size_t)l * DFF * 2048, DFF, 2048, (bf16_t*)(ws + WS_WDN) + (size_t)l * 2048 * DFF, 0, scr, r, lane);
    }
}

struct Row32 { f32x4 v[8]; };
DI void ld_row_f32(Row32& r, const float* p, int lane) {
#pragma unroll
    for (int j = 0; j < 4; ++j) { const f32x4* q = (const f32x4*)(p + j * 512 + lane * 8); r.v[2 * j] = q[0]; r.v[2 * j + 1] = q[1]; }
}
DI void st_row_f32(const Row32& r, float* p, int lane) {
#pragma unroll
    for (int j = 0; j < 4; ++j) { f32x4* q = (f32x4*)(p + j * 512 + lane * 8); q[0] = r.v[2 * j]; q[1] = r.v[2 * j + 1]; }
}
DI void ld_row_bf16(Row32& r, const bf16_t* p, int lane) {
#pragma unroll
    for (int j = 0; j < 4; ++j) { const u32x4 w = *(const u32x4*)(p + j * 512 + lane * 8);
        r.v[2 * j] = (f32x4){bflo(w.x), bfhi(w.x), bflo(w.y), bfhi(w.y)}; r.v[2 * j + 1] = (f32x4){bflo(w.z), bfhi(w.z), bflo(w.w), bfhi(w.w)}; }
}
DI void ld_row_part4(Row32& r, const float* p, int lane) {
    Row32 t; ld_row_f32(r, p, lane);
#pragma unroll
    for (int z = 1; z < 4; ++z) { ld_row_f32(t, p + (size_t)z * MCTX * DM, lane);
#pragma unroll
        for (int i = 0; i < 8; ++i) r.v[i] += t.v[i]; }
}
DI void st_row_bf16(const Row32& r, bf16_t* p, int lane) {
#pragma unroll
    for (int j = 0; j < 4; ++j) *(u32x4*)(p + j * 512 + lane * 8) = pack8(r.v[2 * j], r.v[2 * j + 1]);
}
DI float row_rms_scale(const Row32& r) {
    float s = 0.f;
#pragma unroll
    for (int i = 0; i < 8; ++i) s += (r.v[i].x * r.v[i].x + r.v[i].y * r.v[i].y) + (r.v[i].z * r.v[i].z + r.v[i].w * r.v[i].w);
    s = wave_sum(s);
    return 1.0f / sqrtf(s * (1.f / DM) + EPS);
}
DI void norm_mod_store(const Row32& x, float rs, const float* g, const float* shift, const float* scale, bf16_t* dst, int lane) {
    Row32 gg, sh, sc, o; ld_row_f32(gg, g, lane); ld_row_f32(sh, shift, lane); ld_row_f32(sc, scale, lane);
#pragma unroll
    for (int i = 0; i < 8; ++i) o.v[i] = (x.v[i] * rs * gg.v[i]) * (1.f + sc.v[i]) + sh.v[i];
    st_row_bf16(o, dst, lane);
}
DI int row_mod_idx(int g) { return g < MLAT ? (g >> 12) : 8; }

DI void ew_h0(ArgsRef a) {
    const int tid = tid_opaque(), lane = tid & 63, gw = blockIdx.x * 8 + (tid >> 6), NGW = gridDim.x * 8;
    const float* MODS = (const float*)(a.ws + WS_MODS); bf16_t* H = (bf16_t*)(a.ws + WS_H);
    for (int g = gw; g < MALL; g += NGW) {
        const float* xr = g < MLAT ? a.in[I_X] + (size_t)g * DM : a.in[I_CTX] + (size_t)(g - MLAT) * DM;
        Row32 x; ld_row_f32(x, xr, lane);
        const float rs = row_rms_scale(x);
        const float* md = MODS + (size_t)row_mod_idx(g) * NMODS;
        norm_mod_store(x, rs, a.in[I_GPREMIX], md + 0 * DM, md + 1 * DM, H + hpad_row(g) * DM, lane);
    }
}
DI void ew1(ArgsRef a, int l) {
    const int tid = tid_opaque(), lane = tid & 63, gw = blockIdx.x * 8 + (tid >> 6), NGW = gridDim.x * 8;
    const float* MODS = (const float*)(a.ws + WS_MODS) + (size_t)l * 9 * NMODS; bf16_t* H = (bf16_t*)(a.ws + WS_H);
    const bf16_t* MIX = (const bf16_t*)(a.ws + WS_MIX); float* CX = (float*)(a.ws + WS_CX);
    const int nrows = l == 0 ? MALL : MLAT;
    auto xin = [&](int g) -> const float* { return g < MLAT ? (l == 0 ? a.in[I_X] + (size_t)g * DM : a.out + (size_t)g * DM) : a.in[I_CTX] + (size_t)(g - MLAT) * DM; };
    auto load = [&](int g, Row32& mx, Row32& x) {
        if (g < MLAT) ld_row_bf16(mx, MIX + (size_t)g * DM, lane); else ld_row_part4(mx, (const float*)(a.ws + WS_PART) + (size_t)(g - MLAT) * DM, lane);
        if (l == 0) ld_row_f32(x, xin(g), lane); else ld_row_bf16(x, (const bf16_t*)xin(g), lane); };
    auto finish = [&](int g, Row32& mx, Row32& x) {
        float* xo = g < MLAT ? a.out + (size_t)g * DM : CX + (size_t)(g - MLAT) * DM;
        const float* md = MODS + (size_t)row_mod_idx(g) * NMODS;
        Row32 t;
        const float r1 = row_rms_scale(mx);
        ld_row_f32(t, a.in[I_GPOSTMIX] + l * DM, lane);
#pragma unroll
        for (int i = 0; i < 8; ++i) mx.v[i] = mx.v[i] * r1 * t.v[i];
        ld_row_f32(t, md + 2 * DM, lane);
#pragma unroll
        for (int i = 0; i < 8; ++i) x.v[i] = x.v[i] + t.v[i] * mx.v[i];
        st_row_bf16(x, (bf16_t*)xo, lane);
        const float r2 = row_rms_scale(x);
        norm_mod_store(x, r2, a.in[I_GPREFFN] + l * DM, md + 3 * DM, md + 4 * DM, H + hpad_row(g) * DM, lane); };
    for (int g = gw; g < nrows; g += 2 * NGW) {
        const int g2 = g + NGW; const bool has2 = g2 < nrows;
        Row32 mxA, xA, mxB, xB;
        load(g, mxA, xA);
        if (has2) load(g2, mxB, xB);
        finish(g, mxA, xA);
        if (has2) finish(g2, mxB, xB);
    }
}
DI void ew2(ArgsRef a, int l) {
    const int tid = tid_opaque(), lane = tid & 63, gw = blockIdx.x * 8 + (tid >> 6), NGW = gridDim.x * 8;
    const float* MODS = (const float*)(a.ws + WS_MODS) + (size_t)l * 9 * NMODS; bf16_t* H = (bf16_t*)(a.ws + WS_H);
    const bf16_t* Y = (const bf16_t*)(a.ws + WS_Y); float* CX = (float*)(a.ws + WS_CX);
    const int nrows = l == 0 ? MALL : MLAT;
    auto xrow = [&](int g) -> float* { return g < MLAT ? a.out + (size_t)g * DM : CX + (size_t)(g - MLAT) * DM; };
    auto load = [&](int g, Row32& y, Row32& x) {
        if (g < MLAT) ld_row_bf16(y, Y + (size_t)g * DM, lane); else ld_row_part4(y, (const float*)(a.ws + WS_PART) + (size_t)(g - MLAT) * DM, lane);
        ld_row_bf16(x, (const bf16_t*)xrow(g), lane); };
    auto finish = [&](int g, Row32& y, Row32& x) {
        float* xo = xrow(g);
        const float* md = MODS + (size_t)row_mod_idx(g) * NMODS;
        Row32 t;
        const float r1 = row_rms_scale(y);
        ld_row_f32(t, a.in[I_GPOSTFFN] + l * DM, lane);
#pragma unroll
        for (int i = 0; i < 8; ++i) y.v[i] = y.v[i] * r1 * t.v[i];
        ld_row_f32(t, md + 5 * DM, lane);
#pragma unroll
        for (int i = 0; i < 8; ++i) x.v[i] = x.v[i] + t.v[i] * y.v[i];
        if (l == 0) st_row_bf16(x, (bf16_t*)xo, lane); else st_row_f32(x, xo, lane);
        if (l == 0) {
            const float r2 = row_rms_scale(x);
            const float* md1 = md + (size_t)9 * NMODS;
            norm_mod_store(x, r2, a.in[I_GPREMIX] + DM, md1 + 0 * DM, md1 + 1 * DM, H + hpad_row(g) * DM, lane);
        } };
    for (int g = gw; g < nrows; g += 2 * NGW) {
        const int g2 = g + NGW; const bool has2 = g2 < nrows;
        Row32 yA, xA, yB, xB;
        load(g, yA, xA);
        if (has2) load(g2, yB, xB);
        finish(g, yA, xA);
        if (has2) finish(g2, yB, xB);
    }
}

#define MFMA32(a, b, c) __builtin_amdgcn_mfma_f32_32x32x16_bf16((a), (b), (c), 0, 0, 0)
DI void attn_phase(LAS unsigned char* lds, ArgsRef a, int l, int vcu, int G) {
    const int tid = tid_opaque(), lane = tid & 63, wid = __builtin_amdgcn_readfirstlane(tid >> 6), li = lane & 31, hg = lane >> 5;
    const bf16_t* QH = (const bf16_t*)(a.ws + WS_QH); const bf16_t* KH = (const bf16_t*)(a.ws + WS_KH); const bf16_t* VT = (const bf16_t*)(a.ws + WS_VT);
    bf16_t* MIXCAT = (bf16_t*)(a.ws + WS_MIXCAT);
    LAS float* tab = (LAS float*)lds;
    __syncthreads();
    { const float* rp = a.in[I_RPB] + (size_t)l * 16 * 465; for (int i = tid; i < 16 * 465; i += 512) tab[i] = rp[i] * LOG2E; }
    __syncthreads();
    const int NLAT = 8192, nitems = NLAT + (l == 0 ? 1024 : 0);
    const float SC = 0.125f * LOG2E;
    const int pil = (li & 0x13) | ((li & 4) << 1) | ((li & 8) >> 1);
    constexpr int KL_OFF = 32768, KL_PITCH = 144, VL_OFF = KL_OFF + 256 * KL_PITCH, VL_PITCH = 528;
    static_assert(VL_OFF + 64 * VL_PITCH <= 131072, "attention LDS map");
    for (int bi = vcu; bi * 8 < nitems; bi += G) {
        const int item = bi * 8 + wid;
        const bool isctx = item >= NLAT;
        int b, h, row = 0, gq0;
        if (!isctx) { row = item & 63; h = (item >> 6) & 15; b = item >> 10; gq0 = b * TL + row * 64 + li; }
        else { const int it = item - NLAT, qb = it & 7; h = (it >> 3) & 15; b = it >> 7; gq0 = MLAT + b * TCX + qb * 32 + li; }
        __syncthreads();
        {
            const char* ksrc = (const char*)(KH + ((size_t)h * MALL + MLAT + b * TCX) * 64);
            const char* vsrc = (const char*)(VT + (size_t)(h * 64) * MALL + MLAT + b * TCX);
            u32x4 kv[4], vv[4];
#pragma unroll
            for (int i = 0; i < 4; ++i) { const int q = tid + 512 * i; kv[i] = *(const u32x4*)(ksrc + (size_t)q * 16); vv[i] = *(const u32x4*)(vsrc + (size_t)(q >> 5) * MALL * 2 + (q & 31) * 16); }
#pragma unroll
            for (int i = 0; i < 4; ++i) { const int q = tid + 512 * i;
                *(LAS u32x4*)(lds + KL_OFF + (q >> 3) * KL_PITCH + (q & 7) * 16) = kv[i];
                *(LAS u32x4*)(lds + VL_OFF + (q >> 5) * VL_PITCH + (q & 31) * 16) = vv[i]; }
        }
        __syncthreads();
        const int rs = row - 4 < 0 ? 0 : (row - 4 > 56 ? 56 : row - 4);
        bf16x8 qfA[4], qfB[4];
        { const bf16x8* qp = (const bf16x8*)(QH + ((size_t)h * MALL + gq0) * 64 + hg * 32);
#pragma unroll
          for (int c = 0; c < 4; ++c) { qfA[c] = qp[c]; qfB[c] = isctx ? qp[c] : qp[c + 32 * 8]; } }
        f32x16 oA0, oA1, oB0, oB1;
#pragma unroll
        for (int i = 0; i < 16; ++i) { oA0[i] = 0.f; oA1[i] = 0.f; oB0[i] = 0.f; oB1[i] = 0.f; }
        float mA = -1e30f, lA = 0.f, mB = -1e30f, lB = 0.f;
        const int ntiles = isctx ? 8 : 24;
        for (int t = 0; t < ntiles; ++t) {
            const bool loc = t >= 8;
            int gk0, kr = 0, cb = 0;
            if (!loc) gk0 = MLAT + b * TCX + 32 * t;
            else { const int tt = t - 8; kr = rs + (tt >> 1); cb = tt & 1; gk0 = b * TL + kr * 64 + 32 * cb; }
            bf16x8 kf[4], vf[2][2];
            if (!loc) {
                const LAS bf16x8* kp = (const LAS bf16x8*)(lds + KL_OFF + (32 * t + pil) * KL_PITCH + hg * 64);
#pragma unroll
                for (int c = 0; c < 4; ++c) kf[c] = kp[c];
#pragma unroll
                for (int db = 0; db < 2; ++db)
#pragma unroll
                    for (int j = 0; j < 2; ++j) vf[db][j] = *(const LAS bf16x8*)(lds + VL_OFF + (db * 32 + li) * VL_PITCH + (32 * t + 16 * j + 8 * hg) * 2);
            } else {
                const bf16x8* kp = (const bf16x8*)(KH + ((size_t)h * MALL + gk0 + pil) * 64 + hg * 32);
#pragma unroll
                for (int c = 0; c < 4; ++c) kf[c] = kp[c];
#pragma unroll
                for (int db = 0; db < 2; ++db)
#pragma unroll
                    for (int j = 0; j < 2; ++j) vf[db][j] = *(const bf16x8*)(VT + (size_t)(h * 64 + db * 32 + li) * MALL + gk0 + 16 * j + 8 * hg);
            }
            auto half_body = [&](auto HC, const bf16x8 (&qf)[4], f32x16& o0, f32x16& o1, float& mrun, float& lrun) {
                constexpr int HALF = decltype(HC)::value;
                const int qcol = 32 * HALF + li;
                const int cs = qcol - 8 < 0 ? 0 : (qcol - 8 > 48 ? 48 : qcol - 8);
                f32x16 s;
#pragma unroll
                for (int i = 0; i < 16; ++i) s[i] = 0.f;
#pragma unroll
                for (int c = 0; c < 4; ++c) s = MFMA32(kf[c], qf[c], s);
                float mx = -1e30f;
                if (loc) {
                    const int tb = (h * 15 + (kr - row) + 7) * 31 + 15 - qcol + 32 * cb + 8 * hg;
                    const int kc0 = 32 * cb + 8 * hg;
#pragma unroll
                    for (int r = 0; r < 4; ++r)
#pragma unroll
                        for (int i = 0; i < 4; ++i) {
                            const int kt = 16 * (r >> 1) + 4 * (r & 1) + i, kc = kc0 + kt;
                            const bool valid = (kc >= cs) && (kc < cs + 16);
                            const float bias = tab[valid ? tb + kt : 0];
                            const float v = valid ? s[4 * r + i] * SC + bias : -1e30f;
                            s[4 * r + i] = v; mx = fmaxf(mx, v);
                        }
                } else {
#pragma unroll
                    for (int i = 0; i < 16; ++i) { const float v = s[i] * SC; s[i] = v; mx = fmaxf(mx, v); }
                }
                mx = fmaxf(mx, __shfl_xor(mx, 32));
                const float mnew = fmaxf(mrun, mx), alpha = __builtin_amdgcn_exp2f(mrun - mnew);
                mrun = mnew;
                if (__builtin_amdgcn_ballot_w64(alpha != 1.0f) != 0ull) {
#pragma unroll
                    for (int i = 0; i < 16; ++i) { o0[i] *= alpha; o1[i] *= alpha; }
                }
                auto pv_chunk = [&](auto JC) { constexpr int J = decltype(JC)::value;
                    float ps = 0.f;
#pragma unroll
                    for (int i = 0; i < 8; ++i) { const float p = __builtin_amdgcn_exp2f(s[8 * J + i] - mnew); s[8 * J + i] = p; ps += p; }
                    u32x4 pw; pw.x = pk2(s[8 * J + 0], s[8 * J + 1]); pw.y = pk2(s[8 * J + 2], s[8 * J + 3]); pw.z = pk2(s[8 * J + 4], s[8 * J + 5]); pw.w = pk2(s[8 * J + 6], s[8 * J + 7]);
                    const bf16x8 pf = __builtin_bit_cast(bf16x8, pw);
                    o0 = MFMA32(vf[0][J], pf, o0);
                    o1 = MFMA32(vf[1][J], pf, o1);
                    return ps; };
                float ps;
                if (!loc || cb == HALF) { ps = pv_chunk(std::integral_constant<int, 0>{}); ps += pv_chunk(std::integral_constant<int, 1>{}); }
                else ps = pv_chunk(std::integral_constant<int, HALF>{});
                lrun = lrun * alpha + ps;
            };
            half_body(std::integral_constant<int, 0>{}, qfA, oA0, oA1, mA, lA);
            if (!isctx) half_body(std::integral_constant<int, 1>{}, qfB, oB0, oB1, mB, lB);
        }
        auto store_half = [&](int gq, const f32x16& o0, const f32x16& o1, float lrun) {
            const float ltot = lrun + __shfl_xor(lrun, 32), inv = 1.f / ltot;
            bf16_t* op = MIXCAT + (size_t)gq * DM + h * 64 + 4 * hg;
#pragma unroll
            for (int r = 0; r < 4; ++r) {
                u32x2 w0; w0.x = pk2(o0[4 * r] * inv, o0[4 * r + 1] * inv); w0.y = pk2(o0[4 * r + 2] * inv, o0[4 * r + 3] * inv);
                u32x2 w1; w1.x = pk2(o1[4 * r] * inv, o1[4 * r + 1] * inv); w1.y = pk2(o1[4 * r + 2] * inv, o1[4 * r + 3] * inv);
                *(u32x2*)(op + 8 * r) = w0; *(u32x2*)(op + 32 + 8 * r) = w1;
            } };
        store_half(gq0, oA0, oA1, lA);
        if (!isctx) store_half(gq0 + 32, oB0, oB1, lB);
    }
}

#define XB_TMO      128
#define XB_XCNT(j)  (256  + 64 * (j))
#define XB_XSUB(j)  (1280 + 64 * (j))
#define XB_XGEN(j)  (2304 + 64 * (j))
#define XB_TOP      3328
#define XB_TOPGEN   3392
#define XCD_BAR_WORDS 3456
#define XB_SPIN_CAP (1u << 18)

__device__ __forceinline__ unsigned xb_ld(unsigned* p)              { return __hip_atomic_load(p, __ATOMIC_RELAXED, __HIP_MEMORY_SCOPE_AGENT); }
__device__ __forceinline__ unsigned xb_add(unsigned* p, unsigned v) { return __hip_atomic_fetch_add(p, v, __ATOMIC_RELAXED, __HIP_MEMORY_SCOPE_AGENT); }
__device__ __forceinline__ unsigned xb_xcc_id() { return (unsigned)__builtin_amdgcn_s_getreg((3 << 11) | 20) & 0xFu; }
#define XB_SPIN(cond, bar) do { unsigned _sp = 0; while (cond) { __builtin_amdgcn_s_sleep(1); \
    if ((++_sp & 255u) == 0u) { if (xb_ld(&(bar)[XB_TMO])) break; if (_sp > XB_SPIN_CAP) { atomicAdd(&(bar)[XB_TMO], 1u); break; } } } } while (0)

struct XcdBarrier {
    unsigned* bar; unsigned x;
    volatile LAS unsigned* st;
};

__device__ __forceinline__ XcdBarrier xcd_barrier_post(unsigned* bar, volatile LAS unsigned* st) {
    XcdBarrier b; b.bar = bar; b.x = xb_xcc_id(); b.st = st;
    if (threadIdx.x == 0) (void)xb_add(&bar[XB_XCNT(b.x)], 1u);
    return b;
}
__device__ __forceinline__ void xcd_barrier_complete(unsigned* bar, unsigned x, unsigned& nloc, unsigned& nx) {
    const unsigned G = gridDim.x * gridDim.y * gridDim.z;
    unsigned sum, cnt, mine, sp = 0u;
    for (;;) {
        sum = 0u; cnt = 0u; mine = 0u;
#pragma unroll
        for (unsigned j = 0; j < 16; ++j) { const unsigned c = xb_ld(&bar[XB_XCNT(j)]); sum += c; cnt += (c > 0u) ? 1u : 0u; mine = (j == x) ? c : mine; }
        if (sum == G) break;
        __builtin_amdgcn_s_sleep(1);
        if ((++sp & 255u) == 0u) { if (xb_ld(&bar[XB_TMO])) break; if (sp > XB_SPIN_CAP) { atomicAdd(&bar[XB_TMO], 1u); break; } }
    }
    nloc = mine > 0u ? mine : 1u; nx = cnt > 0u ? cnt : 1u;
}

__device__ __forceinline__ void xcd_barrier(const XcdBarrier& b) {
    asm volatile("s_waitcnt vmcnt(0)" ::: "memory");
    __syncthreads();
    if (threadIdx.x == 0) {
        unsigned* bar = b.bar;
        __builtin_amdgcn_s_waitcnt(0);
        unsigned nloc = b.st[0], nx = b.st[1];
        if (nloc == 0u) { xcd_barrier_complete(bar, b.x, nloc, nx); b.st[0] = nloc; b.st[1] = nx; }
        const unsigned old = xb_add(&bar[XB_XSUB(b.x)], 1u);
        const unsigned gen = old / nloc;
        if (old + 1u == (gen + 1u) * nloc) {
            __builtin_amdgcn_fence(__ATOMIC_RELEASE, "agent");
            asm volatile("s_waitcnt vmcnt(0)" ::: "memory");
            const unsigned og = xb_add(&bar[XB_TOP], 1u);
            const unsigned tg = og / nx;
            if (og + 1u == (tg + 1u) * nx) xb_add(&bar[XB_TOPGEN], 1u);
            else XB_SPIN(xb_ld(&bar[XB_TOPGEN]) == tg, bar);
            __builtin_amdgcn_fence(__ATOMIC_ACQUIRE, "agent");
            xb_add(&bar[XB_XGEN(b.x)], 1u);
            asm volatile("s_waitcnt vmcnt(0)" ::: "memory");
        } else {
            XB_SPIN(xb_ld(&bar[XB_XGEN(b.x)]) == gen, bar);
            __builtin_amdgcn_fence(__ATOMIC_ACQUIRE, "agent");
            asm volatile("s_waitcnt vmcnt(0)" ::: "memory");
        }
    }
    __syncthreads();
}

__global__ void __launch_bounds__(512, 2) mega_fwd(Args args_by_value) {
    extern __shared__ __attribute__((aligned(16))) unsigned char lds_raw[];
    LAS unsigned char* lds = (LAS unsigned char*)lds_raw;
    const int G = gridDim.x, bx = blockIdx.x;
    const int vcu = (G % 8 == 0) ? (bx % 8) * (G / 8) + bx / 8 : bx;
    const int ph_lo = args_by_value.ph_lo, ph_hi = args_by_value.ph_hi;
    const bool one_launch = (ph_hi - ph_lo) > 1;
    if (one_launch) {
        if (threadIdx.x < 2) ((volatile LAS unsigned*)(lds + LDS_MISC))[threadIdx.x] = 0u;
        __syncthreads();
        (void)xcd_barrier_post((unsigned*)(args_by_value.ws + WS_BAR), (volatile LAS unsigned*)(lds + LDS_MISC));
    }
    for (int ph = ph_lo; ph < ph_hi; ++ph) {
        const CAS Args* ap = (const CAS Args*)__builtin_amdgcn_kernarg_segment_ptr();
        asm volatile("" : "+s"(ap));
        ArgsRef args = *ap;
        unsigned char* ws = args.ws;
        for (int rep = 0; rep <= ((PROBE_DUP >> ph) & 1); ++rep) {
        if (ph == 0) p0_prologue(lds, args);
        else if (ph == 1) ew_h0(args);
        else {
            const int l = (ph - 2) / 10, sub = (ph - 2) - 10 * l;
            const int nMrows = (l == 0) ? MALL / 256 : MLAT / 256;
            Sched S; S.base = (const char*)ws; S.G = G; S.c = bx; S.sAz = 0; S.sBz = 0; S.nZ = 1; S.kstepA = 128; S.kstepB = 128; S.bmode = 0;
            if (sub == 0) {
                S.A = (unsigned)WS_H; S.B = (unsigned)(WS_WIN + (size_t)l * 4096 * 2048 * 2); S.lda2 = DM * 2; S.ldb2 = DM * 2; S.nM = MALL / 256; S.nN = 16; S.mode = 1;
                EpiQKVF E{(bf16_t*)(ws + WS_QH), (bf16_t*)(ws + WS_KH), (bf16_t*)(ws + WS_VT), (bf16_t*)(ws + WS_F)};
                gemm_phase(lds, S, E, DM);
            } else if (sub == 1) {
                S.A = (unsigned)(WS_WCS + (size_t)l * 8 * 256 * 128 * 2); S.sAz = 256 * 128 * 2; S.B = (unsigned)WS_F; S.sBz = 128 * 2; S.lda2 = 128 * 2; S.ldb2 = 1024 * 2;
                S.nM = 1; S.nZ = 8; S.mode = 0;
                const int npass = (l == 0) ? 2 : 1;
                for (int pass = 0; pass < npass; ++pass) {
                    EpiGT E{(bf16_t*)(ws + WS_GT), (bf16_t*)(ws + WS_GTC), pass};
                    if (pass == 0) { S.nN = 128; S.bmode = 1; } else { S.nN = 8; S.bmode = 0; S.B = (unsigned)(WS_F + (size_t)MLAT * 1024 * 2); }
                    gemm_phase(lds, S, E, 128);
                }
            } else if (sub == 2) {
                const bool a_first = ((bx >> 3) & 1) == 0;
                for (int step = 0; step < 2; ++step) {
                    if ((step == 0) == a_first) {
                        S.A = (unsigned)WS_MA; S.sAz = 0; S.lda2 = 128 * 2; S.kstepA = 128; S.B = (unsigned)WS_GT; S.sBz = 1024u * 8192u * 2u; S.ldb2 = 0; S.kstepB = 8192; S.bmode = 2;
                        S.nM = 1; S.nN = 256; S.nZ = 8; S.mode = 0;
                        EpiStageA E{(bf16_t*)(ws + WS_YP), (const float*)(ws + WS_TW)};
                        gemm_phase(lds, S, E, 128);
                        if (l == 0) {
                            EpiF2 E2; E2.MIXCAT = (bf16_t*)(ws + WS_MIXCAT); E2.scale = 0.0625f; E2.rowbase = MLAT; E2.rpz = TCX;
                            S.A = (unsigned)WS_DFT256; S.B = (unsigned)WS_GTC; S.sAz = 0; S.sBz = 1024u * 512u * 2u; S.lda2 = 512 * 2; S.ldb2 = 512 * 2; S.kstepA = 128; S.kstepB = 128; S.bmode = 0;
                            S.nM = 1; S.nN = 4; S.nZ = 8; S.mode = 0;
                            gemm_phase(lds, S, E2, 512);
                        }
                    } else attn_phase(lds, args, l, vcu, G);
                    __syncthreads();
                }
            } else if (sub == 3) {
                S.A = (unsigned)WS_MB; S.sAz = 0; S.lda2 = 128 * 2; S.B = (unsigned)WS_YP; S.sBz = 1024u * 128u * 2u; S.ldb2 = 128 * 2;
                S.nM = 1; S.nN = 4; S.nZ = 512; S.mode = 0;
                EpiStageB E{(bf16_t*)(ws + WS_MIXCAT)};
                gemm_phase(lds, S, E, 128);
            } else if (sub == 4 || sub == 8) {
                EpiPlain E; E.ldc = DM; int K;
                if (sub == 4) { S.A = (unsigned)WS_MIXCAT; S.B = (unsigned)(WS_WOUT + (size_t)l * 2048 * 2048 * 2); S.lda2 = DM * 2; S.ldb2 = DM * 2; K = DM; E.C = (bf16_t*)(ws + WS_MIX); }
                else { S.A = (unsigned)WS_ACT; S.B = (unsigned)(WS_WDN + (size_t)l * 2048 * DFF * 2); S.lda2 = DFF * 2; S.ldb2 = DFF * 2; K = DFF; E.C = (bf16_t*)(ws + WS_Y); }
                S.nM = MLAT / 256; S.nN = 8; S.mode = 0;
                gemm_phase(lds, S, E, K);
                if (l == 0) {
                    EpiF32Part EP{(float*)(ws + WS_PART)};
                    S.A += (unsigned)((size_t)MLAT * S.lda2); S.nM = MCTX / 256; S.nZ = 4; S.sAz = (unsigned)(K / 4) * 2u; S.sBz = (unsigned)(K / 4) * 2u;
                    gemm_phase(lds, S, EP, K / 4);
                }
            } else if (sub == 5) ew1(args, l);
            else if (sub == 6) {
                S.A = (unsigned)WS_H; S.B = (unsigned)(WS_WUP + (size_t)l * DFF2 * 2048 * 2); S.lda2 = DM * 2; S.ldb2 = DM * 2; S.nM = nMrows; S.nN = 44; S.mode = 1;
                EpiUpConv E{(bf16_t*)(ws + WS_ACT), (bf16_t*)(ws + WS_RAW), args.in[I_CONVW] + (size_t)l * 3 * DFF2, args.in[I_CONVB] + (size_t)l * DFF2};
                gemm_phase(lds, S, E, DM);
            } else if (sub == 7) { up_fixup(args, l);
            } else ew2(args, l);
        }
        }
        if (ph + 1 < ph_hi) {
            if (ph == ph_lo) cg::this_grid().sync();
            else { XcdBarrier xb; xb.bar = (unsigned*)(ws + WS_BAR); xb.x = xb_xcc_id(); xb.st = (volatile LAS unsigned*)(lds + LDS_MISC); xcd_barrier(xb); }
        }
#ifdef PROBE_SYNC
        if (ph == 1) for (int q = 0; q < PROBE_SYNC; ++q) cg::this_grid().sync();
#endif
    }
}

extern "C" void kernel_launch(void* const* d_in, const int* in_sizes, int n_in, void* d_out, int out_size, void* d_ws, size_t ws_size, hipStream_t stream) {
    static int grid = 0;
    if (grid == 0) {
        int dev = 0, cus = 0, per_cu = 0;
        if (n_in != 18 || ws_size < WS_END) { fprintf(stderr, "kernel_launch: unexpected n_in %d / ws %zu\n", n_in, ws_size); grid = -1; return; }
        (void)hipGetDevice(&dev); (void)hipDeviceGetAttribute(&cus, hipDeviceAttributeMultiprocessorCount, dev);
        if (hipFuncSetAttribute((const void*)mega_fwd, hipFuncAttributeMaxDynamicSharedMemorySize, LDS_BYTES) != hipSuccess) { fprintf(stderr, "kernel_launch: hipFuncSetAttribute failed\n"); grid = -1; return; }
        if (hipOccupancyMaxActiveBlocksPerMultiprocessor(&per_cu, (const void*)mega_fwd, 512, LDS_BYTES) != hipSuccess || per_cu < 1) per_cu = 1;
        (void)hipGetLastError();
        grid = cus * per_cu;
    }
    if (grid < 0) return;
    Args a{};
    for (int i = 0; i < 18; ++i) a.in[i] = (const float*)d_in[i];
    a.out = (float*)d_out; a.ws = (unsigned char*)d_ws;
#if MK_MULTI
    for (int ph = 0; ph < NPH; ++ph) { a.ph_lo = ph; a.ph_hi = ph + 1; hipLaunchKernelGGL(mega_fwd, dim3(grid), dim3(512), LDS_BYTES, stream, a); }
#else
    a.ph_lo = 0; a.ph_hi = NPH;
    if (hipMemsetAsync((char*)d_ws + WS_BAR, 0, XCD_BAR_WORDS * 4, stream) != hipSuccess) { fprintf(stderr, "kernel_launch: memset of barrier words failed\n"); return; }
    void* params[] = {&a};
    hipError_t e = hipLaunchCooperativeKernel((const void*)mega_fwd, dim3(grid), dim3(512), params, LDS_BYTES, stream);
    if (e != hipSuccess) fprintf(stderr, "cooperative launch failed: %s (grid %d)\n", hipGetErrorString(e), grid);
#endif
}
```

```cpp
#include <hip/hip_runtime.h>
#include <hip/hip_cooperative_groups.h>
#include <cstdio>
#include <cstdint>
#include <type_traits>
namespace cg = cooperative_groups;

#ifndef MK_MULTI
#define MK_MULTI 0
#endif

#ifndef G_SP2
#define G_SP2 1
#endif
#ifndef G_ALIGN
#define G_ALIGN 1
#endif
#ifndef PROBE_DUP
#define PROBE_DUP 0
#endif
#define LAS __attribute__((address_space(3)))
#define DI __device__ __forceinline__
typedef unsigned short bf16_t;
typedef short bf16x8 __attribute__((ext_vector_type(8)));
typedef float f32x2 __attribute__((ext_vector_type(2)));
typedef float f32x4 __attribute__((ext_vector_type(4)));
typedef float f32x16 __attribute__((ext_vector_type(16)));
typedef unsigned u32x2 __attribute__((ext_vector_type(2)));
typedef unsigned u32x4 __attribute__((ext_vector_type(4)));
typedef __bf16 bf16x2v __attribute__((ext_vector_type(2)));

DI unsigned pk2(float lo, float hi) { f32x2 v = {lo, hi}; return __builtin_bit_cast(unsigned, __builtin_convertvector(v, bf16x2v)); }
DI float bflo(unsigned u) { return __builtin_bit_cast(float, u << 16); }
DI float bfhi(unsigned u) { return __builtin_bit_cast(float, u & 0xffff0000u); }

constexpr int DM = 2048, NBATCH = 8, TL = 4096, TCX = 256;
constexpr int MLAT = NBATCH * TL, MCTX = NBATCH * TCX, MALL = MLAT + MCTX;
constexpr int NH = 16, DFF = 5632, DFF2 = 11264, NMODS = 12288;
constexpr int LPAD = TL + 2, CPAD = TCX + 2, CTXPB0 = NBATCH * LPAD;
constexpr int HROWS = CTXPB0 + NBATCH * CPAD + 64;
constexpr float EPS = 1e-6f, LOG2E = 1.4426950408889634f;
constexpr int NPH = 22;

constexpr size_t MiB = 1u << 20;
constexpr size_t WS_MODS = 0, WS_WCS = 1 * MiB, WS_DFT256 = 2 * MiB, WS_CX = 3 * MiB, WS_WIN = 19 * MiB, WS_WOUT = 51 * MiB,
                 WS_WUP = 67 * MiB, WS_WDN = 155 * MiB, WS_DFTN = 199 * MiB, WS_H = 263 * MiB, WS_PROJ = 400 * MiB,
                 WS_GT = 672 * MiB, WS_GTC = 800 * MiB, WS_MIXCAT = 808 * MiB, WS_RAW = 944 * MiB, WS_END = 992 * MiB;
constexpr size_t WS_QH = WS_PROJ, WS_KH = WS_PROJ + 68 * MiB, WS_VT = WS_PROJ + 136 * MiB, WS_F = WS_PROJ + 204 * MiB;
constexpr size_t WS_YP = WS_PROJ;
constexpr size_t WS_MA = WS_DFT256 + 256 * 1024, WS_MB = WS_MA + 64 * 1024, WS_TW = WS_MB + 64 * 1024;
constexpr size_t WS_PART = WS_DFTN;
constexpr size_t WS_MIX = WS_PROJ;
constexpr size_t WS_ACT = WS_PROJ;
constexpr size_t WS_Y = WS_MIXCAT;
static_assert((size_t)HROWS * DM * 2 <= WS_PROJ - WS_H, "H");
static_assert((size_t)MALL * DFF * 2 <= WS_MIXCAT - WS_PROJ, "ACT");

constexpr int LDS_BYTES = 147456, LDS_MISC = 131072;
constexpr size_t WS_BAR = WS_MODS + 880 * 1024;

struct Args { const float* in[18]; float* out; unsigned char* ws; int ph_lo, ph_hi; };
#define CAS __attribute__((address_space(4)))
typedef const CAS Args& ArgsRef;
DI int tid_opaque() { int t = threadIdx.x; asm volatile("" : "+v"(t)); return t; }
enum { I_X = 0, I_C, I_CTX, I_CCTX, I_WADA, I_BADA, I_GPREMIX, I_WIN, I_RPB, I_WFOUR, I_WOUT, I_GPOSTMIX, I_GPREFFN, I_WUP, I_CONVW, I_CONVB, I_WDOWN, I_GPOSTFFN };

constexpr int BM = 256, BK = 64, HALF = 128, HTB = HALF * BK * 2, NXCD = 8, WGM = 8;
DI int lds_byte(int r, int c) { const int st = (r >> 4) * 2 + (c >> 5), rr = r & 15, cc = c & 31, ob = rr * 64 + cc * 2; return st * 1024 + (ob ^ (((ob >> 9) & 1) << 5)); }
DI void stage_rc(int b, int& R, int& C) { const int st = b / 1024, sb = b % 1024, swz = sb ^ (((sb >> 9) & 1) << 5); R = (st >> 1) * 16 + swz / 64; C = (st & 1) * 32 + (swz % 64) / 2; }
DI int perm32(int rho) { const int n = rho >> 4, i = rho & 15; return 8 * (i >> 2) + 4 * n + (i & 3); }

struct Unit { unsigned a0, a1, a2, a3, b; int pm, pn, z; };

DI long hpad_row(int g) { return g < MLAT ? (long)(g >> 12) * LPAD + 1 + (g & 4095) : (long)CTXPB0 + (long)CPAD * ((g - MLAT) >> 8) + 1 + ((g - MLAT) & 255); }
DI void strip_info(int sg, long& prow, int& seqrow0, int& T, int& k) {
    if (sg < 536) { const int seq = sg / 67; k = sg - 67 * seq; prow = (long)seq * LPAD + 62 * k; seqrow0 = seq * TL; T = TL; }
    else { const int s2 = sg - 536, seq = s2 / 5; k = s2 - 5 * seq; prow = (long)CTXPB0 + (long)CPAD * seq + 62 * k; seqrow0 = MLAT + seq * TCX; T = TCX; }
}

struct Sched {
    const char* base; unsigned A, B, sAz, sBz, kstepA, kstepB; int lda2, ldb2, nM, nN, nZ, mode, bmode, G, c;
    DI bool next(int i, Unit& u) const {
        const long L = (long)i * G + c; const int nMz = nM * nZ, nwg = nMz * nN; if (L >= nwg) return false;
        int wgid = (int)L; { const int q = nwg / NXCD, r = nwg % NXCD, xcd = wgid % NXCD, off = wgid / NXCD; wgid = (xcd < r ? xcd * (q + 1) : r * (q + 1) + (xcd - r) * q) + off; }
        const int nig = WGM * nN, gid = wgid / nig, fm = gid * WGM, gsz = (nMz - fm) < WGM ? (nMz - fm) : WGM;
        const int pmz = fm + ((wgid % nig) % gsz); u.pn = (wgid % nig) / gsz;
        const int z = pmz / nM, pm = pmz - z * nM; u.pm = pm; u.z = z;
        if (bmode == 0) u.b = B + (unsigned)z * sBz + (unsigned)u.pn * 256u * (unsigned)ldb2;
        else if (bmode == 1) u.b = B + (unsigned)z * sBz + (unsigned)((u.pn >> 4) * 4096 + 4 * (u.pn & 15)) * (unsigned)ldb2;
        else u.b = B + (unsigned)z * sBz + (unsigned)u.pn * 4u * 16384u;
        if (mode == 0) { const unsigned a = A + (unsigned)z * sAz + (unsigned)pm * 256u * (unsigned)lda2; u.a0 = a; u.a1 = a + 64u * lda2; u.a2 = a + 128u * lda2; u.a3 = a + 192u * lda2; }
        else if (mode == 1) { const int g = pm * 256; u.a0 = A + (unsigned)hpad_row(g) * lda2; u.a1 = A + (unsigned)hpad_row(g + 64) * lda2; u.a2 = A + (unsigned)hpad_row(g + 128) * lda2; u.a3 = A + (unsigned)hpad_row(g + 192) * lda2; }
        else { long p; int s0, T, k; strip_info(4 * pm, p, s0, T, k); u.a0 = A + (unsigned)p * lda2; strip_info(4 * pm + 1, p, s0, T, k); u.a1 = A + (unsigned)p * lda2;
               strip_info(4 * pm + 2, p, s0, T, k); u.a2 = A + (unsigned)p * lda2; strip_info(4 * pm + 3, p, s0, T, k); u.a3 = A + (unsigned)p * lda2; }
        return true;
    }
};

template <class Epi>
DI void gemm_phase(LAS unsigned char* lds, const Sched& S, const Epi& E, const int K) {
    const int tid = tid_opaque(), wid = __builtin_amdgcn_readfirstlane(tid >> 6), lane = tid & 63, wr = wid >> 2, wc = wid & 3, fr = lane & 15, fq = lane >> 4;
    const int nt = K / BK;
    unsigned voffA[2], voffB[2];
#pragma unroll
    for (int i = 0; i < 2; ++i) { int R, C; stage_rc(tid * 16 + i * 8192, R, C); const int Rb = (R & ~31) + perm32(R & 31);
        voffA[i] = (unsigned)((R & 63) * S.lda2 + C * 2);
        voffB[i] = S.bmode == 0 ? (unsigned)(Rb * S.ldb2 + C * 2) : S.bmode == 1 ? (unsigned)(((Rb >> 6) + 64 * (Rb & 63)) * S.ldb2 + C * 2) : (unsigned)((Rb >> 6) * 16384 + (Rb & 63) * 128 + C * 2); }
    const unsigned hstepB = S.bmode == 0 ? (unsigned)HALF * S.ldb2 : S.bmode == 1 ? 2u * S.ldb2 : 2u * 16384u;
    const unsigned kstepA = S.kstepA, kstepB = S.kstepB;
    const char* const gbase = S.base;
    const unsigned ldsw = (unsigned)wid * 1024u;
    const int aoff = lds_byte(wr * 64 + fr, fq * 8), boff = lds_byte(wc * 32 + fr, fq * 8);
#define G_SA(b, h) (((b) * 2 + (h)) * HTB)
#define G_SB(b, h) ((4 + (b) * 2 + (h)) * HTB)
#define G_STAGE_A(bufoff, p0, p1, koff) do { \
        __builtin_amdgcn_global_load_lds((const unsigned*)(gbase + (size_t)(unsigned)((p0) + (koff) + voffA[0])), (LAS unsigned*)(lds + (bufoff) + ldsw), 16, 0, 0); \
        __builtin_amdgcn_global_load_lds((const unsigned*)(gbase + (size_t)(unsigned)((p1) + (koff) + voffA[1])), (LAS unsigned*)(lds + (bufoff) + ldsw + 8192), 16, 0, 0); } while (0)
#define G_STAGE_B(bufoff, p, koff) do { \
        __builtin_amdgcn_global_load_lds((const unsigned*)(gbase + (size_t)(unsigned)((p) + (koff) + voffB[0])), (LAS unsigned*)(lds + (bufoff) + ldsw), 16, 0, 0); \
        __builtin_amdgcn_global_load_lds((const unsigned*)(gbase + (size_t)(unsigned)((p) + (koff) + voffB[1])), (LAS unsigned*)(lds + (bufoff) + ldsw + 8192), 16, 0, 0); } while (0)
#define G_LDA(dst, b, h) do { _Pragma("unroll") for (int m = 0; m < 4; ++m) _Pragma("unroll") for (int k = 0; k < 2; ++k) dst[m][k] = *(const LAS bf16x8*)(lds + G_SA(b, h) + aoff + m * 2048 + k * 1024); } while (0)
#define G_LDB(dst, b, h) do { _Pragma("unroll") for (int n = 0; n < 2; ++n) _Pragma("unroll") for (int k = 0; k < 2; ++k) dst[n][k] = *(const LAS bf16x8*)(lds + G_SB(b, h) + boff + n * 2048 + k * 1024); } while (0)
#define G_MMA(ai, bj, At, Bt) do { __builtin_amdgcn_s_setprio(1); _Pragma("unroll") for (int m = 0; m < 4; ++m) _Pragma("unroll") for (int n = 0; n < 2; ++n) _Pragma("unroll") for (int k = 0; k < 2; ++k) \
        acc[ai][bj][m][n] = __builtin_amdgcn_mfma_f32_16x16x32_bf16(Bt[n][k], At[m][k], acc[ai][bj][m][n], 0, 0, 0); __builtin_amdgcn_s_setprio(0); } while (0)
#define G_WAIT_V(n) asm volatile("s_waitcnt vmcnt(" #n ")" ::: "memory")
#define G_WAIT_L(n) asm volatile("s_waitcnt lgkmcnt(" #n ")" ::: "memory")
#define G_BAR __builtin_amdgcn_s_barrier()
#define G_SCHED __builtin_amdgcn_sched_barrier(0)
    Unit cur, nxt; int ui = 0;
    if (!S.next(0, cur)) return;
    f32x4 acc[2][2][4][2];
#pragma unroll
    for (int a = 0; a < 2; ++a)
#pragma unroll
        for (int b = 0; b < 2; ++b)
#pragma unroll
            for (int m = 0; m < 4; ++m)
#pragma unroll
                for (int n = 0; n < 2; ++n) acc[a][b][m][n] = (f32x4){0.f, 0.f, 0.f, 0.f};
    bf16x8 At[4][2], B0[2][2], B1[2][2];
#if G_SP2
    G_STAGE_B(G_SB(0, 0), cur.b, 0u); G_STAGE_B(G_SB(0, 1), cur.b + hstepB, 0u); G_STAGE_A(G_SA(0, 0), cur.a0, cur.a1, 0u); G_STAGE_A(G_SA(0, 1), cur.a2, cur.a3, 0u);
    if (wr == 1) G_BAR;
    G_WAIT_V(2); G_BAR;
#else
    G_STAGE_B(G_SB(0, 0), cur.b, 0u); G_STAGE_A(G_SA(0, 0), cur.a0, cur.a1, 0u); G_STAGE_B(G_SB(0, 1), cur.b + hstepB, 0u); G_STAGE_A(G_SA(0, 1), cur.a2, cur.a3, 0u);
    if (wr == 1) G_BAR;
    G_WAIT_V(4); G_BAR;
#endif
    G_STAGE_B(G_SB(1, 0), cur.b, kstepB); G_STAGE_A(G_SA(1, 0), cur.a0, cur.a1, kstepA); G_STAGE_B(G_SB(1, 1), cur.b + hstepB, kstepB);
    G_WAIT_V(6); G_BAR;
    for (;;) {
        const bool has_next = S.next(ui + 1, nxt);
        const unsigned n0 = has_next ? nxt.a0 : cur.a0, n1 = has_next ? nxt.a1 : cur.a1, n2 = has_next ? nxt.a2 : cur.a2, n3 = has_next ? nxt.a3 : cur.a3;
        const unsigned nB = has_next ? nxt.b : cur.b;
        for (int t = 0; t < nt; t += 2) {
            const bool last = (t == nt - 2);
            const unsigned k1 = (unsigned)(t + 1) * kstepA;
            const unsigned k2 = last ? 0u : (unsigned)(t + 2) * kstepA, k3 = k2 + kstepA;
            const unsigned kb2 = last ? 0u : (unsigned)(t + 2) * kstepB, kb3 = kb2 + kstepB;
            const unsigned x0 = last ? n0 : cur.a0, x1 = last ? n1 : cur.a1, x2 = last ? n2 : cur.a2, x3 = last ? n3 : cur.a3;
            const unsigned xb = last ? nB : cur.b;
#if G_SP2
            G_LDB(B0, 0, 0); G_LDB(B1, 0, 1); G_SCHED; G_LDA(At, 0, 0); G_STAGE_A(G_SA(1, 1), cur.a2, cur.a3, k1);
            G_WAIT_V(8); G_WAIT_L(0); G_BAR; G_MMA(0, 0, At, B0); G_MMA(0, 1, At, B1); G_BAR; G_SCHED;
            G_LDA(At, 0, 1); G_STAGE_B(G_SB(0, 0), xb, kb2); G_STAGE_B(G_SB(0, 1), xb + hstepB, kb2); G_STAGE_A(G_SA(0, 0), x0, x1, k2);
            G_WAIT_V(8); G_WAIT_L(0); G_BAR; G_MMA(1, 0, At, B0); G_MMA(1, 1, At, B1); G_BAR; G_SCHED;
            G_LDB(B0, 1, 0); G_LDB(B1, 1, 1); G_SCHED; G_LDA(At, 1, 0); G_STAGE_A(G_SA(0, 1), x2, x3, k2);
            G_WAIT_V(8); G_WAIT_L(0); G_BAR; G_MMA(0, 0, At, B0); G_MMA(0, 1, At, B1); G_BAR; G_SCHED;
            G_LDA(At, 1, 1); G_STAGE_B(G_SB(1, 0), xb, kb3); G_STAGE_B(G_SB(1, 1), xb + hstepB, kb3); G_STAGE_A(G_SA(1, 0), x0, x1, k3);
            G_WAIT_V(8); G_WAIT_L(0); G_BAR; G_MMA(1, 0, At, B0); G_MMA(1, 1, At, B1); G_BAR; G_SCHED;
#else
            G_LDB(B0, 0, 0); G_SCHED; G_LDA(At, 0, 0); G_STAGE_A(G_SA(1, 1), cur.a2, cur.a3, k1);
            G_WAIT_L(8); G_BAR; G_WAIT_L(0); G_MMA(0, 0, At, B0); G_BAR; G_SCHED;
            G_LDB(B1, 0, 1); G_STAGE_B(G_SB(0, 0), xb, kb2);
            G_BAR; G_WAIT_L(0); G_MMA(0, 1, At, B1); G_BAR;
            G_LDA(At, 0, 1); G_STAGE_A(G_SA(0, 0), x0, x1, k2);
            G_BAR; G_WAIT_L(0); G_MMA(1, 0, At, B0); G_BAR; G_SCHED;
            G_STAGE_B(G_SB(0, 1), xb + hstepB, kb2);
            G_WAIT_V(6); G_BAR; G_MMA(1, 1, At, B1); G_BAR;
            G_LDB(B0, 1, 0); G_SCHED; G_LDA(At, 1, 0); G_STAGE_A(G_SA(0, 1), x2, x3, k2);
            G_WAIT_L(8); G_BAR; G_WAIT_L(0); G_MMA(0, 0, At, B0); G_BAR; G_SCHED;
            G_LDB(B1, 1, 1); G_STAGE_B(G_SB(1, 0), xb, kb3);
            G_BAR; G_WAIT_L(0); G_MMA(0, 1, At, B1); G_BAR;
            G_LDA(At, 1, 1); G_STAGE_A(G_SA(1, 0), x0, x1, k3);
            G_BAR; G_WAIT_L(0); G_MMA(1, 0, At, B0); G_BAR; G_SCHED;
            G_STAGE_B(G_SB(1, 1), xb + hstepB, kb3);
            G_WAIT_V(6); G_BAR; G_MMA(1, 1, At, B1); G_BAR;
        #endif
        }
#if G_ALIGN
        if (wr == 0) G_BAR;
#endif
        E(acc, cur, wr, wc, fr, fq);
        if (!has_next) break;
#pragma unroll
        for (int a = 0; a < 2; ++a)
#pragma unroll
            for (int b = 0; b < 2; ++b)
#pragma unroll
                for (int m = 0; m < 4; ++m)
#pragma unroll
                    for (int n = 0; n < 2; ++n) acc[a][b][m][n] = (f32x4){0.f, 0.f, 0.f, 0.f};
        cur = nxt; ++ui;
#if G_ALIGN
        if (wr == 1) G_BAR;
#endif
    }
    G_WAIT_V(0);
#if !G_ALIGN
    if (wr == 0) G_BAR;
#endif
    G_BAR;
}

DI u32x4 pack8(const f32x4& v0, const f32x4& v1) { u32x4 w; w.x = pk2(v0[0], v0[1]); w.y = pk2(v0[2], v0[3]); w.z = pk2(v1[0], v1[1]); w.w = pk2(v1[2], v1[3]); return w; }

struct EpiPlain {
    bf16_t* C; int ldc;
    DI void operator()(const f32x4 (&acc)[2][2][4][2], const Unit& u, int wr, int wc, int fr, int fq) const {
        const int row0 = u.pm * 256 + wr * 64 + fr, col0 = u.pn * 256 + wc * 32 + 8 * fq;
#pragma unroll
        for (int ai = 0; ai < 2; ++ai)
#pragma unroll
            for (int m = 0; m < 4; ++m) { bf16_t* rowp = C + (size_t)(row0 + ai * 128 + m * 16) * ldc + col0;
#pragma unroll
                for (int bj = 0; bj < 2; ++bj) *(u32x4*)(rowp + bj * 128) = pack8(acc[ai][bj][m][0], acc[ai][bj][m][1]); }
    }
};

struct EpiF32Part {
    float* P;
    DI void operator()(const f32x4 (&acc)[2][2][4][2], const Unit& u, int wr, int wc, int fr, int fq) const {
        const int row0 = u.pm * 256 + wr * 64 + fr, col0 = u.pn * 256 + wc * 32 + 8 * fq;
        float* base = P + (size_t)u.z * MCTX * DM;
#pragma unroll
        for (int ai = 0; ai < 2; ++ai)
#pragma unroll
            for (int m = 0; m < 4; ++m) { float* rowp = base + (size_t)(row0 + ai * 128 + m * 16) * DM + col0;
#pragma unroll
                for (int bj = 0; bj < 2; ++bj) { *(f32x4*)(rowp + bj * 128) = acc[ai][bj][m][0]; *(f32x4*)(rowp + bj * 128 + 4) = acc[ai][bj][m][1]; } }
    }
};

struct EpiQKVF {
    bf16_t *QH, *KH, *VT, *F;
    DI void operator()(const f32x4 (&acc)[2][2][4][2], const Unit& u, int wr, int wc, int fr, int fq) const {
        const int kind = u.pn >> 2, sub = u.pn & 3;
        const int row0 = u.pm * 256 + wr * 64 + fr;
#pragma unroll
        for (int ai = 0; ai < 2; ++ai)
#pragma unroll
            for (int m = 0; m < 4; ++m) {
                const int row = row0 + ai * 128 + m * 16;
#pragma unroll
                for (int bj = 0; bj < 2; ++bj) {
                    const int cl = 128 * bj + 32 * wc + 8 * fq, head = sub * 4 + (cl >> 6), d0 = cl & 63;
                    const u32x4 w = pack8(acc[ai][bj][m][0], acc[ai][bj][m][1]);
                    if (kind == 0) *(u32x4*)(QH + ((size_t)head * MALL + row) * 64 + d0) = w;
                    else if (kind == 1) *(u32x4*)(KH + ((size_t)head * MALL + row) * 64 + d0) = w;
                    else if (kind == 3) *(u32x4*)(F + (size_t)row * 1024 + sub * 256 + cl) = w;
                    else { bf16_t* vp = VT + (size_t)(head * 64 + d0) * MALL + row;
                        vp[0] = (bf16_t)(w.x & 0xffffu); vp[(size_t)MALL] = (bf16_t)(w.x >> 16); vp[(size_t)2 * MALL] = (bf16_t)(w.y & 0xffffu); vp[(size_t)3 * MALL] = (bf16_t)(w.y >> 16);
                        vp[(size_t)4 * MALL] = (bf16_t)(w.z & 0xffffu); vp[(size_t)5 * MALL] = (bf16_t)(w.z >> 16); vp[(size_t)6 * MALL] = (bf16_t)(w.w & 0xffffu); vp[(size_t)7 * MALL] = (bf16_t)(w.w >> 16); }
                }
            }
    }
};

struct EpiGT {
    bf16_t *GT, *GTC; int ctx;
    DI void operator()(const f32x4 (&acc)[2][2][4][2], const Unit& u, int wr, int wc, int fr, int fq) const {
#pragma unroll
        for (int ai = 0; ai < 2; ++ai)
#pragma unroll
            for (int m = 0; m < 4; ++m) {
                const int e = wr * 64 + m * 16 + fr;
#pragma unroll
                for (int bj = 0; bj < 2; ++bj) {
                    const int cl = 128 * bj + 32 * wc + 8 * fq;
                    const u32x4 w = pack8(acc[ai][bj][m][0], acc[ai][bj][m][1]);
                    if (!ctx) { const int b = u.pn >> 4, n0 = (4 * (u.pn & 15) + (cl >> 6)) * 64 + (cl & 63); *(u32x4*)(GT + ((size_t)(b * 1024 + u.z * 128 + e)) * 8192 + ai * 4096 + n0) = w; }
                    else { const int b = u.pn; *(u32x4*)(GTC + ((size_t)(b * 1024 + u.z * 128 + e)) * 512 + ai * 256 + cl) = w; }
                }
            }
    }
};

struct EpiF2 {
    bf16_t* MIXCAT; float scale; int rowbase, rpz;
    DI void operator()(const f32x4 (&acc)[2][2][4][2], const Unit& u, int wr, int wc, int fr, int fq) const {
        const int row0 = rowbase + u.z * rpz + u.pm * 256 + wr * 64 + fr, col0 = 1024 + u.pn * 256 + wc * 32 + 8 * fq;
#pragma unroll
        for (int ai = 0; ai < 2; ++ai)
#pragma unroll
            for (int m = 0; m < 4; ++m) { bf16_t* rowp = MIXCAT + (size_t)(row0 + ai * 128 + m * 16) * DM + col0;
#pragma unroll
                for (int bj = 0; bj < 2; ++bj) *(u32x4*)(rowp + bj * 128) = pack8(acc[ai][bj][m][0] * scale, acc[ai][bj][m][1] * scale); }
    }
};

struct EpiStageA {
    bf16_t* YP; const float* TW;
    DI void operator()(const f32x4 (&acc)[2][2][4][2], const Unit& u, int wr, int wc, int fr, int fq) const {
        if (wr != 0) return;
#pragma unroll
        for (int m = 0; m < 4; ++m) {
            const int k1 = 16 * m + fr;
#pragma unroll
            for (int bj = 0; bj < 2; ++bj) {
                const int j0 = 128 * bj + 32 * wc + 8 * fq, ge = 4 * u.pn + (j0 >> 6), nl0 = j0 & 63;
                const f32x4* tw = (const f32x4*)(TW + (size_t)(k1 * 64 + nl0) * 2);
                f32x4 yr[2], yi[2];
#pragma unroll
                for (int n = 0; n < 2; ++n) {
                    const f32x4 t0 = tw[2 * n], t1 = tw[2 * n + 1];
                    const f32x4 c = {t0.x, t0.z, t1.x, t1.z}, s = {t0.y, t0.w, t1.y, t1.w};
                    const f32x4 r = acc[0][bj][m][n], i = acc[1][bj][m][n];
                    yr[n] = c * r + s * i; yi[n] = c * i - s * r;
                }
                bf16_t* dst = YP + ((((size_t)(u.z * 64 + k1)) * 1024 + ge) * 2) * 64 + nl0;
                *(u32x4*)dst = pack8(yr[0], yr[1]); *(u32x4*)(dst + 64) = pack8(yi[0], yi[1]);
            }
        }
    }
};
struct EpiStageB {
    bf16_t* MIXCAT;
    DI void operator()(const f32x4 (&acc)[2][2][4][2], const Unit& u, int wr, int wc, int fr, int fq) const {
        if (wr != 0) return;
        const int b = u.z >> 6, k1 = u.z & 63;
#pragma unroll
        for (int m = 0; m < 4; ++m) { const int k2 = 16 * m + fr; bf16_t* rowp = MIXCAT + (size_t)(b * 4096 + k1 + 64 * k2) * DM + 1024 + u.pn * 256 + wc * 32 + 8 * fq;
#pragma unroll
            for (int bj = 0; bj < 2; ++bj) *(u32x4*)(rowp + bj * 128) = pack8(acc[0][bj][m][0] * 0.015625f, acc[0][bj][m][1] * 0.015625f); }
    }
};

DI float dpp_ror1(float v) { return __builtin_bit_cast(float, __builtin_amdgcn_update_dpp(0, __builtin_bit_cast(int, v), 0x121, 0xF, 0xF, false)); }
DI float dpp_rol1(float v) { return __builtin_bit_cast(float, __builtin_amdgcn_update_dpp(0, __builtin_bit_cast(int, v), 0x12F, 0xF, 0xF, false)); }

struct EpiUpConv {
    bf16_t* ACT; bf16_t* RAW; const float* cw; const float* cb;
    DI void operator()(const f32x4 (&acc)[2][2][4][2], const Unit& u, int wr, int wc, int fr, int fq) const {
        const int colA = 128 * u.pn + 32 * wc + 8 * fq;
#pragma unroll
        for (int n = 0; n < 2; ++n) {
            const int ca = colA + 4 * n;
            const f32x4 wa0 = *(const f32x4*)(cw + ca), wa1 = *(const f32x4*)(cw + DFF2 + ca), wa2 = *(const f32x4*)(cw + 2 * DFF2 + ca), ba = *(const f32x4*)(cb + ca);
            const f32x4 wg0 = *(const f32x4*)(cw + DFF + ca), wg1 = *(const f32x4*)(cw + DFF2 + DFF + ca), wg2 = *(const f32x4*)(cw + 2 * DFF2 + DFF + ca), bg = *(const f32x4*)(cb + DFF + ca);
#pragma unroll
            for (int ai = 0; ai < 2; ++ai) {
                const int sg = 4 * u.pm + 2 * ai + wr, row0 = 64 * sg;
#pragma unroll
                for (int m = 0; m < 4; ++m) {
                    const int rho = 16 * m + fr;
                    const f32x4 ca_ = acc[ai][0][m][n], cg_ = acc[ai][1][m][n];
                    const f32x4 ua_ = acc[ai][0][m > 0 ? m - 1 : 0][n], ug_ = acc[ai][1][m > 0 ? m - 1 : 0][n];
                    const f32x4 da_ = acc[ai][0][m < 3 ? m + 1 : 3][n], dg_ = acc[ai][1][m < 3 ? m + 1 : 3][n];
                    float o[4];
#pragma unroll
                    for (int j = 0; j < 4; ++j) {
                        const float upa = dpp_ror1(fr == 15 ? ua_[j] : ca_[j]), dna = dpp_rol1(fr == 0 ? da_[j] : ca_[j]);
                        const float upg = dpp_ror1(fr == 15 ? ug_[j] : cg_[j]), dng = dpp_rol1(fr == 0 ? dg_[j] : cg_[j]);
                        const float va = wa0[j] * upa + wa1[j] * ca_[j] + wa2[j] * dna + ba[j];
                        const float vg = wg0[j] * upg + wg1[j] * cg_[j] + wg2[j] * dng + bg[j];
                        const float sgm = vg * __builtin_amdgcn_rcpf(1.f + __builtin_amdgcn_exp2f(-vg * LOG2E));
                        o[j] = sgm * va;
                    }
                    if (rho >= 1 && rho <= 62) { u32x2 w; w.x = pk2(o[0], o[1]); w.y = pk2(o[2], o[3]); *(u32x2*)(ACT + (size_t)(row0 + rho) * DFF + ca) = w; }
                    if (m == 0 || m == 3) {
                        if (rho <= 1 || rho >= 62) { const int slot = rho <= 1 ? rho : rho - 60;
                            bf16_t* rp = RAW + ((size_t)sg * 4 + slot) * DFF2 + ca;
                            u32x2 wa; wa.x = pk2(ca_[0], ca_[1]); wa.y = pk2(ca_[2], ca_[3]); *(u32x2*)rp = wa;
                            u32x2 wg; wg.x = pk2(cg_[0], cg_[1]); wg.y = pk2(cg_[2], cg_[3]); *(u32x2*)(rp + DFF) = wg; }
                    }
                }
            }
        }
    }
};
DI void up_fixup(ArgsRef a, int l) {
    const int tid = tid_opaque(), gtid = blockIdx.x * 512 + tid, NT = gridDim.x * 512;
    const bf16_t* RAW = (const bf16_t*)(a.ws + WS_RAW); bf16_t* ACT = (bf16_t*)(a.ws + WS_ACT);
    const float* cw = a.in[I_CONVW] + (size_t)l * 3 * DFF2; const float* cb = a.in[I_CONVB] + (size_t)l * DFF2;
    const int nstrips = l == 0 ? MALL / 64 : MLAT / 64;
    auto ld4 = [&](const bf16_t* p) -> f32x4 { const u32x2 w = *(const u32x2*)p; return (f32x4){bflo(w.x), bfhi(w.x), bflo(w.y), bfhi(w.y)}; };
    for (int it = gtid; it < nstrips * 2 * (DFF / 4); it += NT) {
        const int c4 = it % (DFF / 4), rw = it / (DFF / 4), sg = rw >> 1, last = rw & 1, ca = 4 * c4;
        const bool first_of_seq = sg < MLAT / 64 ? (sg & 63) == 0 : ((sg - MLAT / 64) & 3) == 0;
        const bool last_of_seq = sg < MLAT / 64 ? (sg & 63) == 63 : ((sg - MLAT / 64) & 3) == 3;
        const bf16_t* cur = RAW + ((size_t)sg * 4 + (last ? 3 : 0)) * DFF2 + ca;
        const bf16_t* up = last ? RAW + ((size_t)sg * 4 + 2) * DFF2 + ca : RAW + ((size_t)(sg - 1) * 4 + 3) * DFF2 + ca;
        const bf16_t* dn = last ? RAW + ((size_t)(sg + 1) * 4 + 0) * DFF2 + ca : RAW + ((size_t)sg * 4 + 1) * DFF2 + ca;
        const bool has_up = last || !first_of_seq, has_dn = !last || !last_of_seq;
        const f32x4 z = {0.f, 0.f, 0.f, 0.f};
        const f32x4 ca_ = ld4(cur), cg_ = ld4(cur + DFF);
        const f32x4 ua_ = has_up ? ld4(up) : z, ug_ = has_up ? ld4(up + DFF) : z;
        const f32x4 da_ = has_dn ? ld4(dn) : z, dg_ = has_dn ? ld4(dn + DFF) : z;
        const f32x4 wa0 = *(const f32x4*)(cw + ca), wa1 = *(const f32x4*)(cw + DFF2 + ca), wa2 = *(const f32x4*)(cw + 2 * DFF2 + ca), ba = *(const f32x4*)(cb + ca);
        const f32x4 wg0 = *(const f32x4*)(cw + DFF + ca), wg1 = *(const f32x4*)(cw + DFF2 + DFF + ca), wg2 = *(const f32x4*)(cw + 2 * DFF2 + DFF + ca), bg = *(const f32x4*)(cb + DFF + ca);
        const f32x4 va = wa0 * ua_ + wa1 * ca_ + wa2 * da_ + ba, vg = wg0 * ug_ + wg1 * cg_ + wg2 * dg_ + bg;
        float o[4];
#pragma unroll
        for (int j = 0; j < 4; ++j) o[j] = vg[j] * __builtin_amdgcn_rcpf(1.f + __builtin_amdgcn_exp2f(-vg[j] * LOG2E)) * va[j];
        u32x2 w; w.x = pk2(o[0], o[1]); w.y = pk2(o[2], o[3]);
        *(u32x2*)(ACT + (size_t)(64 * sg + (last ? 63 : 0)) * DFF + ca) = w;
    }
}

DI float wave_sum(float v) {
#pragma unroll
    for (int o = 1; o < 64; o <<= 1) v += __shfl_xor(v, o);
    return v;
}
#define LDS_WAIT() asm volatile("s_waitcnt lgkmcnt(0)" ::: "memory")

DI void p0_mods_item(LAS unsigned char* lds, ArgsRef a, float* MODS, int item) {
    const int tid = tid_opaque(), l = item / 96, chunk = item - 96 * l;
    LAS float* sc = (LAS float*)lds;
    const float* c = a.in[I_C]; const float* cctx = a.in[I_CCTX];
    for (int i = tid; i < 2048 * 9; i += 512) { const int k = i / 9, b = i - 9 * k; const float v = (b < 8) ? c[b * 2048 + k] : cctx[k]; sc[i] = v / (1.f + __expf(-v)); }
    __syncthreads();
    const int ks = tid >> 5, cgp = tid & 31, col = chunk * 128 + cgp * 4;
    const float* W = a.in[I_WADA] + (size_t)l * 2048 * NMODS + col;
    f32x4 acc[9];
#pragma unroll
    for (int b = 0; b < 9; ++b) acc[b] = (f32x4){0.f, 0.f, 0.f, 0.f};
#pragma unroll 4
    for (int k = ks * 128; k < ks * 128 + 128; ++k) {
        const f32x4 w = *(const f32x4*)(W + (size_t)k * NMODS);
#pragma unroll
        for (int b = 0; b < 9; ++b) acc[b] += sc[k * 9 + b] * w;
    }
    __syncthreads();
    LAS float* red = (LAS float*)lds;
#pragma unroll
    for (int b = 0; b < 9; ++b) *(LAS f32x4*)(red + (ks * 9 + b) * 128 + cgp * 4) = acc[b];
    __syncthreads();
    for (int o = tid; o < 9 * 128; o += 512) { const int b = o >> 7, cc = o & 127; float s = 0.f;
#pragma unroll
        for (int k2 = 0; k2 < 16; ++k2) s += red[(k2 * 9 + b) * 128 + cc];
        MODS[(size_t)(l * 9 + b) * NMODS + chunk * 128 + cc] = s + a.in[I_BADA][l * NMODS + chunk * 128 + cc]; }
    __syncthreads();
}
DI void p0_transpose_item(const float* W, int K, int N, bf16_t* WT, int up_map, LAS float* scr, int item, int lane) {
    const int nblk = N / 32, kb = item / nblk, nb = item - kb * nblk, k0 = 64 * kb, n0 = 32 * nb;
    int rowbase = n0;
    if (up_map) rowbase = (n0 < DFF) ? 256 * (n0 / 128) + (n0 % 128) : 256 * ((n0 - DFF) / 128) + 128 + ((n0 - DFF) % 128);
#pragma unroll 8
    for (int i = 0; i < 32; ++i) { const int kk = 2 * i + (lane >> 5); scr[kk * 33 + (lane & 31)] = W[(size_t)(k0 + kk) * N + n0 + (lane & 31)]; }
    LDS_WAIT(); asm volatile("" ::: "memory");
    const int c = lane & 7;
#pragma unroll
    for (int j = 0; j < 4; ++j) { const int n = (lane >> 3) + 8 * j; const LAS float* s = scr + (8 * c) * 33 + n;
        u32x4 o; o.x = pk2(s[0 * 33], s[1 * 33]); o.y = pk2(s[2 * 33], s[3 * 33]); o.z = pk2(s[4 * 33], s[5 * 33]); o.w = pk2(s[6 * 33], s[7 * 33]);
        *(u32x4*)(WT + (size_t)(rowbase + n) * K + k0 + 8 * c) = o; }
    LDS_WAIT(); asm volatile("" ::: "memory");
}
DI void p0_prologue(LAS unsigned char* lds, ArgsRef a) {
    const int tid = tid_opaque(), lane = tid & 63, wave = tid >> 6, G = gridDim.x, bx = blockIdx.x;
    unsigned char* ws = a.ws;
    __syncthreads();
    for (int item = bx; item < 192; item += G) p0_mods_item(lds, a, (float*)(ws + WS_MODS), item);
    LAS float* tab = (LAS float*)lds;
    __syncthreads();
    for (int p = tid; p < 4096; p += 512) tab[p] = cospif((float)p * (1.f / 2048.f));
    __syncthreads();
    const int gtid = bx * 512 + tid, NT = G * 512;
    {
        bf16_t* MA = (bf16_t*)(ws + WS_MA); bf16_t* MB = (bf16_t*)(ws + WS_MB); float* TW = (float*)(ws + WS_TW);
        for (int i = gtid; i < 256 * 128; i += NT) { const int r = i >> 7, col = i & 127, ri = r >> 7, rr = r & 127, cs = col >> 6, q = col & 63;
            float va = 0.f;
            if (rr < 64) { const int p = (rr * q * 64) & 4095; const float c = tab[p], s = tab[(p - 1024) & 4095]; va = ri == 0 ? (cs == 0 ? c : -s) : (cs == 0 ? -s : -c); }
            MA[i] = (bf16_t)(pk2(va, 0.f) & 0xffffu);
            float vb = 0.f;
            if (r < 64) { const int p = (r * q * 64) & 4095; vb = cs == 0 ? tab[p] : tab[(p - 1024) & 4095]; }
            MB[i] = (bf16_t)(pk2(vb, 0.f) & 0xffffu);
        }
        for (int i = gtid; i < 64 * 64; i += NT) { const int p = ((i >> 6) * (i & 63)) & 4095; TW[2 * i] = tab[p]; TW[2 * i + 1] = tab[(p - 1024) & 4095]; }
        bf16_t* D256 = (bf16_t*)(ws + WS_DFT256);
        for (int ch = gtid; ch < 256 * 64; ch += NT) { const int kp = ch >> 6, j0 = (ch & 63) * 8, cs = j0 >> 8, n0 = j0 & 255;
            float v[8];
#pragma unroll
            for (int e = 0; e < 8; ++e) v[e] = tab[((((kp * (n0 + e)) & 255) << 4) + cs * 1024) & 4095];
            u32x4 o; o.x = pk2(v[0], v[1]); o.y = pk2(v[2], v[3]); o.z = pk2(v[4], v[5]); o.w = pk2(v[6], v[7]);
            *(u32x4*)(D256 + (size_t)ch * 8) = o; }
        bf16_t* WCS = (bf16_t*)(ws + WS_WCS);
        for (int ch = gtid; ch < 65536; ch += NT) { const int c0 = (ch & 15) * 8, r = (ch >> 4) & 255, cs = r >> 7, e = r & 127, lg = ch >> 12;
            const float* wf = a.in[I_WFOUR] + (size_t)lg * 128 * 128 + e;
            float v[8];
#pragma unroll
            for (int q = 0; q < 8; ++q) v[q] = 0.f;
            for (int m = 0; m < 128; ++m) { const float w = wf[m * 128];
#pragma unroll
                for (int q = 0; q < 8; ++q) v[q] += w * tab[((((m * (c0 + q)) & 127) << 5) - cs * 1024) & 4095]; }
            const float sc = 0.08838834764831845f;
            u32x4 o; o.x = pk2(v[0] * sc, v[1] * sc); o.y = pk2(v[2] * sc, v[3] * sc); o.z = pk2(v[4] * sc, v[5] * sc); o.w = pk2(v[6] * sc, v[7] * sc);
            *(u32x4*)(WCS + (size_t)ch * 8) = o; }
        bf16_t* H = (bf16_t*)(ws + WS_H);
        for (int i = gtid; i < 32 * 256; i += NT) { const int rr = i >> 8, cc = (i & 255) * 8, seq = rr >> 1, hi = rr & 1;
            const long prow = seq < 8 ? (long)seq * LPAD + (hi ? LPAD - 1 : 0) : (long)CTXPB0 + (long)(seq - 8) * CPAD + (hi ? CPAD - 1 : 0);
            *(u32x4*)(H + prow * DM + cc) = (u32x4){0u, 0u, 0u, 0u}; }
    }
    __syncthreads();
    LAS float* scr = (LAS float*)(lds + wave * 16384);
    const int gw = bx * 8 + wave, NGW = G * 8;
    for (int it = gw; it < 2 * 23040; it += NGW) {
        const int l = it / 23040; int r = it - l * 23040;
        if (r < 4096) { p0_transpose_item(a.in[I_WIN] + (size_t)l * 2048 * 4096, 2048, 4096, (bf16_t*)(ws + WS_WIN) + (size_t)l * 4096 * 2048, 0, scr, r, lane); continue; } r -= 4096;
        if (r < 2048) { p0_transpose_item(a.in[I_WOUT] + (size_t)l * 2048 * 2048, 2048, 2048, (bf16_t*)(ws + WS_WOUT) + (size_t)l * 2048 * 2048, 0, scr, r, lane); continue; } r -= 2048;
        if (r < 11264) { p0_transpose_item(a.in[I_WUP] + (size_t)l * 2048 * DFF2, 2048, DFF2, (bf16_t*)(ws + WS_WUP) + (size_t)l * DFF2 * 2048, 1, scr, r, lane); continue; } r -= 11264;
        p0_transpose_item(a.in[I_WDOWN] + (size_t)l * DFF * 2048, DFF, 2048, (bf16_t*)(ws + WS_WDN) + (size_t)l * 2048 * DFF, 0, scr, r, lane);
    }
}

struct Row32 { f32x4 v[8]; };
DI void ld_row_f32(Row32& r, const float* p, int lane) {
#pragma unroll
    for (int j = 0; j < 4; ++j) { const f32x4* q = (const f32x4*)(p + j * 512 + lane * 8); r.v[2 * j] = q[0]; r.v[2 * j + 1] = q[1]; }
}
DI void st_row_f32(const Row32& r, float* p, int lane) {
#pragma unroll
    for (int j = 0; j < 4; ++j) { f32x4* q = (f32x4*)(p + j * 512 + lane * 8); q[0] = r.v[2 * j]; q[1] = r.v[2 * j + 1]; }
}
DI void ld_row_bf16(Row32& r, const bf16_t* p, int lane) {
#pragma unroll
    for (int j = 0; j < 4; ++j) { const u32x4 w = *(const u32x4*)(p + j * 512 + lane * 8);
        r.v[2 * j] = (f32x4){bflo(w.x), bfhi(w.x), bflo(w.y), bfhi(w.y)}; r.v[2 * j + 1] = (f32x4){bflo(w.z), bfhi(w.z), bflo(w.w), bfhi(w.w)}; }
}
DI void ld_row_part4(Row32& r, const float* p, int lane) {
    Row32 t; ld_row_f32(r, p, lane);
#pragma unroll
    for (int z = 1; z < 4; ++z) { ld_row_f32(t, p + (size_t)z * MCTX * DM, lane);
#pragma unroll
        for (int i = 0; i < 8; ++i) r.v[i] += t.v[i]; }
}
DI void st_row_bf16(const Row32& r, bf16_t* p, int lane) {
#pragma unroll
    for (int j = 0; j < 4; ++j) *(u32x4*)(p + j * 512 + lane * 8) = pack8(r.v[2 * j], r.v[2 * j + 1]);
}
DI float row_rms_scale(const Row32& r) {
    float s = 0.f;
#pragma unroll
    for (int i = 0; i < 8; ++i) s += (r.v[i].x * r.v[i].x + r.v[i].y * r.v[i].y) + (r.v[i].z * r.v[i].z + r.v[i].w * r.v[i].w);
    s = wave_sum(s);
    return 1.0f / sqrtf(s * (1.f / DM) + EPS);
}
DI void norm_mod_store(const Row32& x, float rs, const float* g, const float* shift, const float* scale, bf16_t* dst, int lane) {
    Row32 gg, sh, sc, o; ld_row_f32(gg, g, lane); ld_row_f32(sh, shift, lane); ld_row_f32(sc, scale, lane);
#pragma unroll
    for (int i = 0; i < 8; ++i) o.v[i] = (x.v[i] * rs * gg.v[i]) * (1.f + sc.v[i]) + sh.v[i];
    st_row_bf16(o, dst, lane);
}
DI int row_mod_idx(int g) { return g < MLAT ? (g >> 12) : 8; }

DI void ew_h0(ArgsRef a) {
    const int tid = tid_opaque(), lane = tid & 63, gw = blockIdx.x * 8 + (tid >> 6), NGW = gridDim.x * 8;
    const float* MODS = (const float*)(a.ws + WS_MODS); bf16_t* H = (bf16_t*)(a.ws + WS_H);
    auto xin = [&](int g) -> const float* { return g < MLAT ? a.in[I_X] + (size_t)g * DM : a.in[I_CTX] + (size_t)(g - MLAT) * DM; };
    auto finish = [&](int g, Row32& x) {
        const float rs = row_rms_scale(x);
        const float* md = MODS + (size_t)row_mod_idx(g) * NMODS;
        norm_mod_store(x, rs, a.in[I_GPREMIX], md + 0 * DM, md + 1 * DM, H + hpad_row(g) * DM, lane); };
    for (int g = gw; g < MALL; g += 2 * NGW) {
        const int g2 = g + NGW; const bool has2 = g2 < MALL;
        Row32 xA, xB;
        ld_row_f32(xA, xin(g), lane);
        if (has2) ld_row_f32(xB, xin(g2), lane);
        finish(g, xA);
        if (has2) finish(g2, xB);
    }
}
DI void ew1(ArgsRef a, int l) {
    const int tid = tid_opaque(), lane = tid & 63, gw = blockIdx.x * 8 + (tid >> 6), NGW = gridDim.x * 8;
    const float* MODS = (const float*)(a.ws + WS_MODS) + (size_t)l * 9 * NMODS; bf16_t* H = (bf16_t*)(a.ws + WS_H);
    const bf16_t* MIX = (const bf16_t*)(a.ws + WS_MIX); float* CX = (float*)(a.ws + WS_CX);
    const int nrows = l == 0 ? MALL : MLAT;
    auto xin = [&](int g) -> const float* { return g < MLAT ? (l == 0 ? a.in[I_X] + (size_t)g * DM : a.out + (size_t)g * DM) : a.in[I_CTX] + (size_t)(g - MLAT) * DM; };
    auto load = [&](int g, Row32& mx, Row32& x) {
        if (g < MLAT) ld_row_bf16(mx, MIX + (size_t)g * DM, lane); else ld_row_part4(mx, (const float*)(a.ws + WS_PART) + (size_t)(g - MLAT) * DM, lane);
        if (l == 0) ld_row_f32(x, xin(g), lane); else ld_row_bf16(x, (const bf16_t*)xin(g), lane); };
    auto finish = [&](int g, Row32& mx, Row32& x) {
        float* xo = g < MLAT ? a.out + (size_t)g * DM : CX + (size_t)(g - MLAT) * DM;
        const float* md = MODS + (size_t)row_mod_idx(g) * NMODS;
        Row32 t;
        const float r1 = row_rms_scale(mx);
        ld_row_f32(t, a.in[I_GPOSTMIX] + l * DM, lane);
#pragma unroll
        for (int i = 0; i < 8; ++i) mx.v[i] = mx.v[i] * r1 * t.v[i];
        ld_row_f32(t, md + 2 * DM, lane);
#pragma unroll
        for (int i = 0; i < 8; ++i) x.v[i] = x.v[i] + t.v[i] * mx.v[i];
        st_row_bf16(x, (bf16_t*)xo, lane);
        const float r2 = row_rms_scale(x);
        norm_mod_store(x, r2, a.in[I_GPREFFN] + l * DM, md + 3 * DM, md + 4 * DM, H + hpad_row(g) * DM, lane); };
    for (int g = gw; g < nrows; g += 2 * NGW) {
        const int g2 = g + NGW; const bool has2 = g2 < nrows;
        Row32 mxA, xA, mxB, xB;
        load(g, mxA, xA);
        if (has2) load(g2, mxB, xB);
        finish(g, mxA, xA);
        if (has2) finish(g2, mxB, xB);
    }
}
DI void ew2(ArgsRef a, int l) {
    const int tid = tid_opaque(), lane = tid & 63, gw = blockIdx.x * 8 + (tid >> 6), NGW = gridDim.x * 8;
    const float* MODS = (const float*)(a.ws + WS_MODS) + (size_t)l * 9 * NMODS; bf16_t* H = (bf16_t*)(a.ws + WS_H);
    const bf16_t* Y = (const bf16_t*)(a.ws + WS_Y); float* CX = (float*)(a.ws + WS_CX);
    const int nrows = l == 0 ? MALL : MLAT;
    auto xrow = [&](int g) -> float* { return g < MLAT ? a.out + (size_t)g * DM : CX + (size_t)(g - MLAT) * DM; };
    auto load = [&](int g, Row32& y, Row32& x) {
        if (g < MLAT) ld_row_bf16(y, Y + (size_t)g * DM, lane); else ld_row_part4(y, (const float*)(a.ws + WS_PART) + (size_t)(g - MLAT) * DM, lane);
        ld_row_bf16(x, (const bf16_t*)xrow(g), lane); };
    auto finish = [&](int g, Row32& y, Row32& x) {
        float* xo = xrow(g);
        const float* md = MODS + (size_t)row_mod_idx(g) * NMODS;
        Row32 t;
        const float r1 = row_rms_scale(y);
        ld_row_f32(t, a.in[I_GPOSTFFN] + l * DM, lane);
#pragma unroll
        for (int i = 0; i < 8; ++i) y.v[i] = y.v[i] * r1 * t.v[i];
        ld_row_f32(t, md + 5 * DM, lane);
#pragma unroll
        for (int i = 0; i < 8; ++i) x.v[i] = x.v[i] + t.v[i] * y.v[i];
        if (l == 0) st_row_bf16(x, (bf16_t*)xo, lane); else st_row_f32(x, xo, lane);
        if (l == 0) {
            const float r2 = row_rms_scale(x);
            const float* md1 = md + (size_t)9 * NMODS;
            norm_mod_store(x, r2, a.in[I_GPREMIX] + DM, md1 + 0 * DM, md1 + 1 * DM, H + hpad_row(g) * DM, lane);
        } };
    for (int g = gw; g < nrows; g += 2 * NGW) {
        const int g2 = g + NGW; const bool has2 = g2 < nrows;
        Row32 yA, xA, yB, xB;
        load(g, yA, xA);
        if (has2) load(g2, yB, xB);
        finish(g, yA, xA);
        if (has2) finish(g2, yB, xB);
    }
}

#define MFMA32(a, b, c) __builtin_amdgcn_mfma_f32_32x32x16_bf16((a), (b), (c), 0, 0, 0)
DI void attn_phase(LAS unsigned char* lds, ArgsRef a, int l, int vcu, int G) {
    const int tid = tid_opaque(), lane = tid & 63, wid = __builtin_amdgcn_readfirstlane(tid >> 6), li = lane & 31, hg = lane >> 5;
    const bf16_t* QH = (const bf16_t*)(a.ws + WS_QH); const bf16_t* KH = (const bf16_t*)(a.ws + WS_KH); const bf16_t* VT = (const bf16_t*)(a.ws + WS_VT);
    bf16_t* MIXCAT = (bf16_t*)(a.ws + WS_MIXCAT);
    LAS float* tab = (LAS float*)lds;
    __syncthreads();
    { const float* rp = a.in[I_RPB] + (size_t)l * 16 * 465; for (int i = tid; i < 16 * 465; i += 512) tab[i] = rp[i] * LOG2E; }
    __syncthreads();
    const int NLAT = 8192, nitems = NLAT + (l == 0 ? 1024 : 0);
    const float SC = 0.125f * LOG2E;
    const int pil = (li & 0x13) | ((li & 4) << 1) | ((li & 8) >> 1);
    constexpr int KL_OFF = 32768, KL_PITCH = 144, VL_OFF = KL_OFF + 256 * KL_PITCH, VL_PITCH = 528;
    static_assert(VL_OFF + 64 * VL_PITCH <= 131072, "attention LDS map");
    for (int bi = vcu; bi * 8 < nitems; bi += G) {
        const int item = bi * 8 + wid;
        const bool isctx = item >= NLAT;
        int b, h, row = 0, gq0;
        if (!isctx) { row = item & 63; h = (item >> 6) & 15; b = item >> 10; gq0 = b * TL + row * 64 + li; }
        else { const int it = item - NLAT, qb = it & 7; h = (it >> 3) & 15; b = it >> 7; gq0 = MLAT + b * TCX + qb * 32 + li; }
        __syncthreads();
        {
            const char* ksrc = (const char*)(KH + ((size_t)h * MALL + MLAT + b * TCX) * 64);
            const char* vsrc = (const char*)(VT + (size_t)(h * 64) * MALL + MLAT + b * TCX);
            u32x4 kv[4], vv[4];
#pragma unroll
            for (int i = 0; i < 4; ++i) { const int q = tid + 512 * i; kv[i] = *(const u32x4*)(ksrc + (size_t)q * 16); vv[i] = *(const u32x4*)(vsrc + (size_t)(q >> 5) * MALL * 2 + (q & 31) * 16); }
#pragma unroll
            for (int i = 0; i < 4; ++i) { const int q = tid + 512 * i;
                *(LAS u32x4*)(lds + KL_OFF + (q >> 3) * KL_PITCH + (q & 7) * 16) = kv[i];
                *(LAS u32x4*)(lds + VL_OFF + (q >> 5) * VL_PITCH + (q & 31) * 16) = vv[i]; }
        }
        __syncthreads();
        const int rs = row - 4 < 0 ? 0 : (row - 4 > 56 ? 56 : row - 4);
        bf16x8 qfA[4], qfB[4];
        { const bf16x8* qp = (const bf16x8*)(QH + ((size_t)h * MALL + gq0) * 64 + hg * 32);
#pragma unroll
          for (int c = 0; c < 4; ++c) { qfA[c] = qp[c]; qfB[c] = isctx ? qp[c] : qp[c + 32 * 8]; } }
        f32x16 oA0, oA1, oB0, oB1;
#pragma unroll
        for (int i = 0; i < 16; ++i) { oA0[i] = 0.f; oA1[i] = 0.f; oB0[i] = 0.f; oB1[i] = 0.f; }
        float mA = -1e30f, lA = 0.f, mB = -1e30f, lB = 0.f;
        const int ntiles = isctx ? 8 : 24;
        for (int t = 0; t < ntiles; ++t) {
            const bool loc = t >= 8;
            int gk0, kr = 0, cb = 0;
            if (!loc) gk0 = MLAT + b * TCX + 32 * t;
            else { const int tt = t - 8; kr = rs + (tt >> 1); cb = tt & 1; gk0 = b * TL + kr * 64 + 32 * cb; }
            bf16x8 kf[4], vf[2][2];
            if (!loc) {
                const LAS bf16x8* kp = (const LAS bf16x8*)(lds + KL_OFF + (32 * t + pil) * KL_PITCH + hg * 64);
#pragma unroll
                for (int c = 0; c < 4; ++c) kf[c] = kp[c];
#pragma unroll
                for (int db = 0; db < 2; ++db)
#pragma unroll
                    for (int j = 0; j < 2; ++j) vf[db][j] = *(const LAS bf16x8*)(lds + VL_OFF + (db * 32 + li) * VL_PITCH + (32 * t + 16 * j + 8 * hg) * 2);
            } else {
                const bf16x8* kp = (const bf16x8*)(KH + ((size_t)h * MALL + gk0 + pil) * 64 + hg * 32);
#pragma unroll
                for (int c = 0; c < 4; ++c) kf[c] = kp[c];
#pragma unroll
                for (int db = 0; db < 2; ++db)
#pragma unroll
                    for (int j = 0; j < 2; ++j) vf[db][j] = *(const bf16x8*)(VT + (size_t)(h * 64 + db * 32 + li) * MALL + gk0 + 16 * j + 8 * hg);
            }
            auto half_body = [&](auto HC, const bf16x8 (&qf)[4], f32x16& o0, f32x16& o1, float& mrun, float& lrun) {
                constexpr int HALF = decltype(HC)::value;
                const int qcol = 32 * HALF + li;
                const int cs = qcol - 8 < 0 ? 0 : (qcol - 8 > 48 ? 48 : qcol - 8);
                f32x16 s;
#pragma unroll
                for (int i = 0; i < 16; ++i) s[i] = 0.f;
#pragma unroll
                for (int c = 0; c < 4; ++c) s = MFMA32(kf[c], qf[c], s);
                float mx = -1e30f;
                if (loc) {
                    const int tb = (h * 15 + (kr - row) + 7) * 31 + 15 - qcol + 32 * cb + 8 * hg;
                    const int kc0 = 32 * cb + 8 * hg;
#pragma unroll
                    for (int r = 0; r < 4; ++r)
#pragma unroll
                        for (int i = 0; i < 4; ++i) {
                            const int kt = 16 * (r >> 1) + 4 * (r & 1) + i, kc = kc0 + kt;
                            const bool valid = (kc >= cs) && (kc < cs + 16);
                            const float bias = tab[valid ? tb + kt : 0];
                            const float v = valid ? s[4 * r + i] * SC + bias : -1e30f;
                            s[4 * r + i] = v; mx = fmaxf(mx, v);
                        }
                } else {
#pragma unroll
                    for (int i = 0; i < 16; ++i) { const float v = s[i] * SC; s[i] = v; mx = fmaxf(mx, v); }
                }
                mx = fmaxf(mx, __shfl_xor(mx, 32));
                const float mnew = fmaxf(mrun, mx), alpha = __builtin_amdgcn_exp2f(mrun - mnew);
                mrun = mnew;
                if (__builtin_amdgcn_ballot_w64(alpha != 1.0f) != 0ull) {
#pragma unroll
                    for (int i = 0; i < 16; ++i) { o0[i] *= alpha; o1[i] *= alpha; }
                }
                auto pv_chunk = [&](auto JC) { constexpr int J = decltype(JC)::value;
                    float ps = 0.f;
#pragma unroll
                    for (int i = 0; i < 8; ++i) { const float p = __builtin_amdgcn_exp2f(s[8 * J + i] - mnew); s[8 * J + i] = p; ps += p; }
                    u32x4 pw; pw.x = pk2(s[8 * J + 0], s[8 * J + 1]); pw.y = pk2(s[8 * J + 2], s[8 * J + 3]); pw.z = pk2(s[8 * J + 4], s[8 * J + 5]); pw.w = pk2(s[8 * J + 6], s[8 * J + 7]);
                    const bf16x8 pf = __builtin_bit_cast(bf16x8, pw);
                    o0 = MFMA32(vf[0][J], pf, o0);
                    o1 = MFMA32(vf[1][J], pf, o1);
                    return ps; };
                float ps;
                if (!loc || cb == HALF) { ps = pv_chunk(std::integral_constant<int, 0>{}); ps += pv_chunk(std::integral_constant<int, 1>{}); }
                else ps = pv_chunk(std::integral_constant<int, HALF>{});
                lrun = lrun * alpha + ps;
            };
            half_body(std::integral_constant<int, 0>{}, qfA, oA0, oA1, mA, lA);
            if (!isctx) half_body(std::integral_constant<int, 1>{}, qfB, oB0, oB1, mB, lB);
        }
        auto store_half = [&](int gq, const f32x16& o0, const f32x16& o1, float lrun) {
            const float ltot = lrun + __shfl_xor(lrun, 32), inv = 1.f / ltot;
            bf16_t* op = MIXCAT + (size_t)gq * DM + h * 64 + 4 * hg;
#pragma unroll
            for (int r = 0; r < 4; ++r) {
                u32x2 w0; w0.x = pk2(o0[4 * r] * inv, o0[4 * r + 1] * inv); w0.y = pk2(o0[4 * r + 2] * inv, o0[4 * r + 3] * inv);
                u32x2 w1; w1.x = pk2(o1[4 * r] * inv, o1[4 * r + 1] * inv); w1.y = pk2(o1[4 * r + 2] * inv, o1[4 * r + 3] * inv);
                *(u32x2*)(op + 8 * r) = w0; *(u32x2*)(op + 32 + 8 * r) = w1;
            } };
        store_half(gq0, oA0, oA1, lA);
        if (!isctx) store_half(gq0 + 32, oB0, oB1, lB);
    }
}

#define XB_TMO      128
#define XB_XCNT(j)  (256  + 64 * (j))
#define XB_XSUB(j)  (1280 + 64 * (j))
#define XB_XGEN(j)  (2304 + 64 * (j))
#define XB_TOP      3328
#define XB_TOPGEN   3392
#define XCD_BAR_WORDS 3456
#define XB_SPIN_CAP (1u << 18)

__device__ __forceinline__ unsigned xb_ld(unsigned* p)              { return __hip_atomic_load(p, __ATOMIC_RELAXED, __HIP_MEMORY_SCOPE_AGENT); }
__device__ __forceinline__ unsigned xb_add(unsigned* p, unsigned v) { return __hip_atomic_fetch_add(p, v, __ATOMIC_RELAXED, __HIP_MEMORY_SCOPE_AGENT); }
__device__ __forceinline__ unsigned xb_xcc_id() { return (unsigned)__builtin_amdgcn_s_getreg((3 << 11) | 20) & 0xFu; }
#define XB_SPIN(cond, bar) do { unsigned _sp = 0; while (cond) { __builtin_amdgcn_s_sleep(1); \
    if ((++_sp & 255u) == 0u) { if (xb_ld(&(bar)[XB_TMO])) break; if (_sp > XB_SPIN_CAP) { atomicAdd(&(bar)[XB_TMO], 1u); break; } } } } while (0)

struct XcdBarrier {
    unsigned* bar; unsigned x;
    volatile LAS unsigned* st;
};

__device__ __forceinline__ XcdBarrier xcd_barrier_post(unsigned* bar, volatile LAS unsigned* st) {
    XcdBarrier b; b.bar = bar; b.x = xb_xcc_id(); b.st = st;
    if (threadIdx.x == 0) (void)xb_add(&bar[XB_XCNT(b.x)], 1u);
    return b;
}
__device__ __forceinline__ void xcd_barrier_complete(unsigned* bar, unsigned x, unsigned& nloc, unsigned& nx) {
    const unsigned G = gridDim.x * gridDim.y * gridDim.z;
    unsigned sum, cnt, mine, sp = 0u;
    for (;;) {
        sum = 0u; cnt = 0u; mine = 0u;
#pragma unroll
        for (unsigned j = 0; j < 16; ++j) { const unsigned c = xb_ld(&bar[XB_XCNT(j)]); sum += c; cnt += (c > 0u) ? 1u : 0u; mine = (j == x) ? c : mine; }
        if (sum == G) break;
        __builtin_amdgcn_s_sleep(1);
        if ((++sp & 255u) == 0u) { if (xb_ld(&bar[XB_TMO])) break; if (sp > XB_SPIN_CAP) { atomicAdd(&bar[XB_TMO], 1u); break; } }
    }
    nloc = mine > 0u ? mine : 1u; nx = cnt > 0u ? cnt : 1u;
}

__device__ __forceinline__ void xcd_barrier(const XcdBarrier& b) {
    asm volatile("s_waitcnt vmcnt(0)" ::: "memory");
    __syncthreads();
    if (threadIdx.x == 0) {
        unsigned* bar = b.bar;
        __builtin_amdgcn_s_waitcnt(0);
        unsigned nloc = b.st[0], nx = b.st[1];
        if (nloc == 0u) { xcd_barrier_complete(bar, b.x, nloc, nx); b.st[0] = nloc; b.st[1] = nx; }
        const unsigned old = xb_add(&bar[XB_XSUB(b.x)], 1u);
        const unsigned gen = old / nloc;
        if (old + 1u == (gen + 1u) * nloc) {
            __builtin_amdgcn_fence(__ATOMIC_RELEASE, "agent");
            asm volatile("s_waitcnt vmcnt(0)" ::: "memory");
            const unsigned og = xb_add(&bar[XB_TOP], 1u);
            const unsigned tg = og / nx;
            if (og + 1u == (tg + 1u) * nx) xb_add(&bar[XB_TOPGEN], 1u);
            else XB_SPIN(xb_ld(&bar[XB_TOPGEN]) == tg, bar);
            __builtin_amdgcn_fence(__ATOMIC_ACQUIRE, "agent");
            xb_add(&bar[XB_XGEN(b.x)], 1u);
            asm volatile("s_waitcnt vmcnt(0)" ::: "memory");
        } else {
            XB_SPIN(xb_ld(&bar[XB_XGEN(b.x)]) == gen, bar);
            __builtin_amdgcn_fence(__ATOMIC_ACQUIRE, "agent");
            asm volatile("s_waitcnt vmcnt(0)" ::: "memory");
        }
    }
    __syncthreads();
}

__global__ void __launch_bounds__(512, 2) mega_fwd(Args args_by_value) {
    extern __shared__ __attribute__((aligned(16))) unsigned char lds_raw[];
    LAS unsigned char* lds = (LAS unsigned char*)lds_raw;
    const int G = gridDim.x, bx = blockIdx.x;
    const int vcu = (G % 8 == 0) ? (bx % 8) * (G / 8) + bx / 8 : bx;
    const int ph_lo = args_by_value.ph_lo, ph_hi = args_by_value.ph_hi;
    const bool one_launch = (ph_hi - ph_lo) > 1;
    if (one_launch) {
        if (threadIdx.x < 2) ((volatile LAS unsigned*)(lds + LDS_MISC))[threadIdx.x] = 0u;
        __syncthreads();
        (void)xcd_barrier_post((unsigned*)(args_by_value.ws + WS_BAR), (volatile LAS unsigned*)(lds + LDS_MISC));
    }
    for (int ph = ph_lo; ph < ph_hi; ++ph) {
        const CAS Args* ap = (const CAS Args*)__builtin_amdgcn_kernarg_segment_ptr();
        asm volatile("" : "+s"(ap));
        ArgsRef args = *ap;
        unsigned char* ws = args.ws;
        for (int rep = 0; rep <= ((PROBE_DUP >> ph) & 1); ++rep) {
        if (ph == 0) p0_prologue(lds, args);
        else if (ph == 1) ew_h0(args);
        else {
            const int l = (ph - 2) / 10, sub = (ph - 2) - 10 * l;
            const int nMrows = (l == 0) ? MALL / 256 : MLAT / 256;
            Sched S; S.base = (const char*)ws; S.G = G; S.c = bx; S.sAz = 0; S.sBz = 0; S.nZ = 1; S.kstepA = 128; S.kstepB = 128; S.bmode = 0;
            if (sub == 0) {
                S.A = (unsigned)WS_H; S.B = (unsigned)(WS_WIN + (size_t)l * 4096 * 2048 * 2); S.lda2 = DM * 2; S.ldb2 = DM * 2; S.nM = MALL / 256; S.nN = 16; S.mode = 1;
                EpiQKVF E{(bf16_t*)(ws + WS_QH), (bf16_t*)(ws + WS_KH), (bf16_t*)(ws + WS_VT), (bf16_t*)(ws + WS_F)};
                gemm_phase(lds, S, E, DM);
            } else if (sub == 1) {
                S.A = (unsigned)(WS_WCS + (size_t)l * 8 * 256 * 128 * 2); S.sAz = 256 * 128 * 2; S.B = (unsigned)WS_F; S.sBz = 128 * 2; S.lda2 = 128 * 2; S.ldb2 = 1024 * 2;
                S.nM = 1; S.nZ = 8; S.mode = 0;
                const int npass = (l == 0) ? 2 : 1;
                for (int pass = 0; pass < npass; ++pass) {
                    EpiGT E{(bf16_t*)(ws + WS_GT), (bf16_t*)(ws + WS_GTC), pass};
                    if (pass == 0) { S.nN = 128; S.bmode = 1; } else { S.nN = 8; S.bmode = 0; S.B = (unsigned)(WS_F + (size_t)MLAT * 1024 * 2); }
                    gemm_phase(lds, S, E, 128);
                }
                attn_phase(lds, args, l, vcu, G);
            } else if (sub == 2) {
                {
                    S.A = (unsigned)WS_MA; S.sAz = 0; S.lda2 = 128 * 2; S.kstepA = 128; S.B = (unsigned)WS_GT; S.sBz = 1024u * 8192u * 2u; S.ldb2 = 0; S.kstepB = 8192; S.bmode = 2;
                    S.nM = 1; S.nN = 256; S.nZ = 8; S.mode = 0;
                    EpiStageA E{(bf16_t*)(ws + WS_YP), (const float*)(ws + WS_TW)};
                    gemm_phase(lds, S, E, 128);
                }
                if (l == 0) {
                    EpiF2 E; E.MIXCAT = (bf16_t*)(ws + WS_MIXCAT); E.scale = 0.0625f; E.rowbase = MLAT; E.rpz = TCX;
                    S.A = (unsigned)WS_DFT256; S.B = (unsigned)WS_GTC; S.sAz = 0; S.sBz = 1024u * 512u * 2u; S.lda2 = 512 * 2; S.ldb2 = 512 * 2; S.kstepA = 128; S.kstepB = 128; S.bmode = 0;
                    S.nM = 1; S.nN = 4; S.nZ = 8; S.mode = 0;
                    gemm_phase(lds, S, E, 512);
                }
            } else if (sub == 3) {
                S.A = (unsigned)WS_MB; S.sAz = 0; S.lda2 = 128 * 2; S.B = (unsigned)WS_YP; S.sBz = 1024u * 128u * 2u; S.ldb2 = 128 * 2;
                S.nM = 1; S.nN = 4; S.nZ = 512; S.mode = 0;
                EpiStageB E{(bf16_t*)(ws + WS_MIXCAT)};
                gemm_phase(lds, S, E, 128);
            } else if (sub == 4 || sub == 8) {
                EpiPlain E; E.ldc = DM; int K;
                if (sub == 4) { S.A = (unsigned)WS_MIXCAT; S.B = (unsigned)(WS_WOUT + (size_t)l * 2048 * 2048 * 2); S.lda2 = DM * 2; S.ldb2 = DM * 2; K = DM; E.C = (bf16_t*)(ws + WS_MIX); }
                else { S.A = (unsigned)WS_ACT; S.B = (unsigned)(WS_WDN + (size_t)l * 2048 * DFF * 2); S.lda2 = DFF * 2; S.ldb2 = DFF * 2; K = DFF; E.C = (bf16_t*)(ws + WS_Y); }
                S.nM = MLAT / 256; S.nN = 8; S.mode = 0;
                gemm_phase(lds, S, E, K);
                if (l == 0) {
                    EpiF32Part EP{(float*)(ws + WS_PART)};
                    S.A += (unsigned)((size_t)MLAT * S.lda2); S.nM = MCTX / 256; S.nZ = 4; S.sAz = (unsigned)(K / 4) * 2u; S.sBz = (unsigned)(K / 4) * 2u;
                    gemm_phase(lds, S, EP, K / 4);
                }
            } else if (sub == 5) ew1(args, l);
            else if (sub == 6) {
                S.A = (unsigned)WS_H; S.B = (unsigned)(WS_WUP + (size_t)l * DFF2 * 2048 * 2); S.lda2 = DM * 2; S.ldb2 = DM * 2; S.nM = nMrows; S.nN = 44; S.mode = 1;
                EpiUpConv E{(bf16_t*)(ws + WS_ACT), (bf16_t*)(ws + WS_RAW), args.in[I_CONVW] + (size_t)l * 3 * DFF2, args.in[I_CONVB] + (size_t)l * DFF2};
                gemm_phase(lds, S, E, DM);
            } else if (sub == 7) { up_fixup(args, l);
            } else ew2(args, l);
        }
        }
        if (ph + 1 < ph_hi) {
            if (ph == ph_lo) cg::this_grid().sync();
            else { XcdBarrier xb; xb.bar = (unsigned*)(ws + WS_BAR); xb.x = xb_xcc_id(); xb.st = (volatile LAS unsigned*)(lds + LDS_MISC); xcd_barrier(xb); }
        }
#ifdef PROBE_SYNC
        if (ph == 1) for (int q = 0; q < PROBE_SYNC; ++q) cg::this_grid().sync();
#endif
    }
}

extern "C" void kernel_launch(void* const* d_in, const int* in_sizes, int n_in, void* d_out, int out_size, void* d_ws, size_t ws_size, hipStream_t stream) {
    static int grid = 0;
    if (grid == 0) {
        int dev = 0, cus = 0, per_cu = 0;
        if (n_in != 18 || ws_size < WS_END) { fprintf(stderr, "kernel_launch: unexpected n_in %d / ws %zu\n", n_in, ws_size); grid = -1; return; }
        (void)hipGetDevice(&dev); (void)hipDeviceGetAttribute(&cus, hipDeviceAttributeMultiprocessorCount, dev);
        if (hipFuncSetAttribute((const void*)mega_fwd, hipFuncAttributeMaxDynamicSharedMemorySize, LDS_BYTES) != hipSuccess) { fprintf(stderr, "kernel_launch: hipFuncSetAttribute failed\n"); grid = -1; return; }
        if (hipOccupancyMaxActiveBlocksPerMultiprocessor(&per_cu, (const void*)mega_fwd, 512, LDS_BYTES) != hipSuccess || per_cu < 1) per_cu = 1;
        (void)hipGetLastError();
        grid = cus * per_cu;
    }
    if (grid < 0) return;
    Args a{};
    for (int i = 0; i < 18; ++i) a.in[i] = (const float*)d_in[i];
    a.out = (float*)d_out; a.ws = (unsigned char*)d_ws;
#if MK_MULTI
    for (int ph = 0; ph < NPH; ++ph) { a.ph_lo = ph; a.ph_hi = ph + 1; hipLaunchKernelGGL(mega_fwd, dim3(grid), dim3(512), LDS_BYTES, stream, a); }
#else
    a.ph_lo = 0; a.ph_hi = NPH;
    if (hipMemsetAsync((char*)d_ws + WS_BAR, 0, XCD_BAR_WORDS * 4, stream) != hipSuccess) { fprintf(stderr, "kernel_launch: memset of barrier words failed\n"); return; }
    void* params[] = {&a};
    hipError_t e = hipLaunchCooperativeKernel((const void*)mega_fwd, dim3(grid), dim3(512), params, LDS_BYTES, stream);
    if (e != hipSuccess) fprintf(stderr, "cooperative launch failed: %s (grid %d)\n", hipGetErrorString(e), grid);
#endif
}
```

```cpp
#include <hip/hip_runtime.h>
#include <hip/hip_cooperative_groups.h>
#include <cstdio>
#include <cstdint>
#include <type_traits>
namespace cg = cooperative_groups;

#ifndef MK_MULTI
#define MK_MULTI 0
#endif

#ifndef G_SP2
#define G_SP2 1
#endif
#ifndef G_ALIGN
#define G_ALIGN 1
#endif
#ifndef PROBE_DUP
#define PROBE_DUP 0
#endif
#define LAS __attribute__((address_space(3)))
#define DI __device__ __forceinline__
typedef unsigned short bf16_t;
typedef short bf16x8 __attribute__((ext_vector_type(8)));
typedef float f32x2 __attribute__((ext_vector_type(2)));
typedef float f32x4 __attribute__((ext_vector_type(4)));
typedef float f32x16 __attribute__((ext_vector_type(16)));
typedef unsigned u32x2 __attribute__((ext_vector_type(2)));
typedef unsigned u32x4 __attribute__((ext_vector_type(4)));
typedef __bf16 bf16x2v __attribute__((ext_vector_type(2)));

DI unsigned pk2(float lo, float hi) { f32x2 v = {lo, hi}; return __builtin_bit_cast(unsigned, __builtin_convertvector(v, bf16x2v)); }
DI float bflo(unsigned u) { return __builtin_bit_cast(float, u << 16); }
DI float bfhi(unsigned u) { return __builtin_bit_cast(float, u & 0xffff0000u); }

constexpr int DM = 2048, NBATCH = 8, TL = 4096, TCX = 256;
constexpr int MLAT = NBATCH * TL, MCTX = NBATCH * TCX, MALL = MLAT + MCTX;
constexpr int NH = 16, DFF = 5632, DFF2 = 11264, NMODS = 12288;
constexpr int LPAD = TL + 2, CPAD = TCX + 2, CTXPB0 = NBATCH * LPAD;
constexpr int HROWS = CTXPB0 + NBATCH * CPAD + 64;
constexpr float EPS = 1e-6f, LOG2E = 1.4426950408889634f;
constexpr int NPH = 22;

constexpr size_t MiB = 1u << 20;
constexpr size_t WS_MODS = 0, WS_WCS = 1 * MiB, WS_DFT256 = 2 * MiB, WS_CX = 3 * MiB, WS_WIN = 19 * MiB, WS_WOUT = 51 * MiB,
                 WS_WUP = 67 * MiB, WS_WDN = 155 * MiB, WS_DFTN = 199 * MiB, WS_H = 263 * MiB, WS_PROJ = 400 * MiB,
                 WS_GT = 672 * MiB, WS_GTC = 800 * MiB, WS_MIXCAT = 808 * MiB, WS_RAW = 944 * MiB, WS_END = 992 * MiB;
constexpr size_t WS_QH = WS_PROJ, WS_KH = WS_PROJ + 68 * MiB, WS_VT = WS_PROJ + 136 * MiB, WS_F = WS_PROJ + 204 * MiB;
constexpr size_t WS_YP = WS_PROJ;
constexpr size_t WS_MA = WS_DFT256 + 256 * 1024, WS_MB = WS_MA + 64 * 1024, WS_TW = WS_MB + 64 * 1024;
constexpr size_t WS_PART = WS_DFTN;
constexpr size_t WS_MIX = WS_PROJ;
constexpr size_t WS_ACT = WS_PROJ;
constexpr size_t WS_Y = WS_MIXCAT;
static_assert((size_t)HROWS * DM * 2 <= WS_PROJ - WS_H, "H");
static_assert((size_t)MALL * DFF * 2 <= WS_MIXCAT - WS_PROJ, "ACT");

constexpr int LDS_BYTES = 147456, LDS_MISC = 131072;
constexpr size_t WS_BAR = WS_MODS + 880 * 1024;

struct Args { const float* in[18]; float* out; unsigned char* ws; int ph_lo, ph_hi; };
#define CAS __attribute__((address_space(4)))
typedef const CAS Args& ArgsRef;
DI int tid_opaque() { int t = threadIdx.x; asm volatile("" : "+v"(t)); return t; }
enum { I_X = 0, I_C, I_CTX, I_CCTX, I_WADA, I_BADA, I_GPREMIX, I_WIN, I_RPB, I_WFOUR, I_WOUT, I_GPOSTMIX, I_GPREFFN, I_WUP, I_CONVW, I_CONVB, I_WDOWN, I_GPOSTFFN };

constexpr int BM = 256, BK = 64, HALF = 128, HTB = HALF * BK * 2, NXCD = 8, WGM = 8;
DI int lds_byte(int r, int c) { const int st = (r >> 4) * 2 + (c >> 5), rr = r & 15, cc = c & 31, ob = rr * 64 + cc * 2; return st * 1024 + (ob ^ (((ob >> 9) & 1) << 5)); }
DI void stage_rc(int b, int& R, int& C) { const int st = b / 1024, sb = b % 1024, swz = sb ^ (((sb >> 9) & 1) << 5); R = (st >> 1) * 16 + swz / 64; C = (st & 1) * 32 + (swz % 64) / 2; }
DI int perm32(int rho) { const int n = rho >> 4, i = rho & 15; return 8 * (i >> 2) + 4 * n + (i & 3); }

struct Unit { unsigned a0, a1, a2, a3, b; int pm, pn, z; };

DI long hpad_row(int g) { return g < MLAT ? (long)(g >> 12) * LPAD + 1 + (g & 4095) : (long)CTXPB0 + (long)CPAD * ((g - MLAT) >> 8) + 1 + ((g - MLAT) & 255); }
DI void strip_info(int sg, long& prow, int& seqrow0, int& T, int& k) {
    if (sg < 536) { const int seq = sg / 67; k = sg - 67 * seq; prow = (long)seq * LPAD + 62 * k; seqrow0 = seq * TL; T = TL; }
    else { const int s2 = sg - 536, seq = s2 / 5; k = s2 - 5 * seq; prow = (long)CTXPB0 + (long)CPAD * seq + 62 * k; seqrow0 = MLAT + seq * TCX; T = TCX; }
}

struct Sched {
    const char* base; unsigned A, B, sAz, sBz, kstepA, kstepB; int lda2, ldb2, nM, nN, nZ, mode, bmode, G, c;
    DI bool next(int i, Unit& u) const {
        const long L = (long)i * G + c; const int nMz = nM * nZ, nwg = nMz * nN; if (L >= nwg) return false;
        int wgid = (int)L; { const int q = nwg / NXCD, r = nwg % NXCD, xcd = wgid % NXCD, off = wgid / NXCD; wgid = (xcd < r ? xcd * (q + 1) : r * (q + 1) + (xcd - r) * q) + off; }
        const int nig = WGM * nN, gid = wgid / nig, fm = gid * WGM, gsz = (nMz - fm) < WGM ? (nMz - fm) : WGM;
        const int pmz = fm + ((wgid % nig) % gsz); u.pn = (wgid % nig) / gsz;
        const int z = pmz / nM, pm = pmz - z * nM; u.pm = pm; u.z = z;
        if (bmode == 0) u.b = B + (unsigned)z * sBz + (unsigned)u.pn * 256u * (unsigned)ldb2;
        else if (bmode == 1) u.b = B + (unsigned)z * sBz + (unsigned)((u.pn >> 4) * 4096 + 4 * (u.pn & 15)) * (unsigned)ldb2;
        else u.b = B + (unsigned)z * sBz + (unsigned)u.pn * 4u * 16384u;
        if (mode == 0) { const unsigned a = A + (unsigned)z * sAz + (unsigned)pm * 256u * (unsigned)lda2; u.a0 = a; u.a1 = a + 64u * lda2; u.a2 = a + 128u * lda2; u.a3 = a + 192u * lda2; }
        else if (mode == 1) { const int g = pm * 256; u.a0 = A + (unsigned)hpad_row(g) * lda2; u.a1 = A + (unsigned)hpad_row(g + 64) * lda2; u.a2 = A + (unsigned)hpad_row(g + 128) * lda2; u.a3 = A + (unsigned)hpad_row(g + 192) * lda2; }
        else { long p; int s0, T, k; strip_info(4 * pm, p, s0, T, k); u.a0 = A + (unsigned)p * lda2; strip_info(4 * pm + 1, p, s0, T, k); u.a1 = A + (unsigned)p * lda2;
               strip_info(4 * pm + 2, p, s0, T, k); u.a2 = A + (unsigned)p * lda2; strip_info(4 * pm + 3, p, s0, T, k); u.a3 = A + (unsigned)p * lda2; }
        return true;
    }
};

template <class Epi>
DI void gemm_phase(LAS unsigned char* lds, const Sched& S, const Epi& E, const int K) {
    const int tid = tid_opaque(), wid = __builtin_amdgcn_readfirstlane(tid >> 6), lane = tid & 63, wr = wid >> 2, wc = wid & 3, fr = lane & 15, fq = lane >> 4;
    const int nt = K / BK;
    unsigned voffA[2], voffB[2];
#pragma unroll
    for (int i = 0; i < 2; ++i) { int R, C; stage_rc(tid * 16 + i * 8192, R, C); const int Rb = (R & ~31) + perm32(R & 31);
        voffA[i] = (unsigned)((R & 63) * S.lda2 + C * 2);
        voffB[i] = S.bmode == 0 ? (unsigned)(Rb * S.ldb2 + C * 2) : S.bmode == 1 ? (unsigned)(((Rb >> 6) + 64 * (Rb & 63)) * S.ldb2 + C * 2) : (unsigned)((Rb >> 6) * 16384 + (Rb & 63) * 128 + C * 2); }
    const unsigned hstepB = S.bmode == 0 ? (unsigned)HALF * S.ldb2 : S.bmode == 1 ? 2u * S.ldb2 : 2u * 16384u;
    const unsigned kstepA = S.kstepA, kstepB = S.kstepB;
    const char* const gbase = S.base;
    const unsigned ldsw = (unsigned)wid * 1024u;
    const int aoff = lds_byte(wr * 64 + fr, fq * 8), boff = lds_byte(wc * 32 + fr, fq * 8);
#define G_SA(b, h) (((b) * 2 + (h)) * HTB)
#define G_SB(b, h) ((4 + (b) * 2 + (h)) * HTB)
#define G_STAGE_A(bufoff, p0, p1, koff) do { \
        __builtin_amdgcn_global_load_lds((const unsigned*)(gbase + (size_t)(unsigned)((p0) + (koff) + voffA[0])), (LAS unsigned*)(lds + (bufoff) + ldsw), 16, 0, 0); \
        __builtin_amdgcn_global_load_lds((const unsigned*)(gbase + (size_t)(unsigned)((p1) + (koff) + voffA[1])), (LAS unsigned*)(lds + (bufoff) + ldsw + 8192), 16, 0, 0); } while (0)
#define G_STAGE_B(bufoff, p, koff) do { \
        __builtin_amdgcn_global_load_lds((const unsigned*)(gbase + (size_t)(unsigned)((p) + (koff) + voffB[0])), (LAS unsigned*)(lds + (bufoff) + ldsw), 16, 0, 0); \
        __builtin_amdgcn_global_load_lds((const unsigned*)(gbase + (size_t)(unsigned)((p) + (koff) + voffB[1])), (LAS unsigned*)(lds + (bufoff) + ldsw + 8192), 16, 0, 0); } while (0)
#define G_LDA(dst, b, h) do { _Pragma("unroll") for (int m = 0; m < 4; ++m) _Pragma("unroll") for (int k = 0; k < 2; ++k) dst[m][k] = *(const LAS bf16x8*)(lds + G_SA(b, h) + aoff + m * 2048 + k * 1024); } while (0)
#define G_LDB(dst, b, h) do { _Pragma("unroll") for (int n = 0; n < 2; ++n) _Pragma("unroll") for (int k = 0; k < 2; ++k) dst[n][k] = *(const LAS bf16x8*)(lds + G_SB(b, h) + boff + n * 2048 + k * 1024); } while (0)
#define G_MMA(ai, bj, At, Bt) do { __builtin_amdgcn_s_setprio(1); _Pragma("unroll") for (int m = 0; m < 4; ++m) _Pragma("unroll") for (int n = 0; n < 2; ++n) _Pragma("unroll") for (int k = 0; k < 2; ++k) \
        acc[ai][bj][m][n] = __builtin_amdgcn_mfma_f32_16x16x32_bf16(Bt[n][k], At[m][k], acc[ai][bj][m][n], 0, 0, 0); __builtin_amdgcn_s_setprio(0); } while (0)
#define G_WAIT_V(n) asm volatile("s_waitcnt vmcnt(" #n ")" ::: "memory")
#define G_WAIT_L(n) asm volatile("s_waitcnt lgkmcnt(" #n ")" ::: "memory")
#define G_BAR __builtin_amdgcn_s_barrier()
#define G_SCHED __builtin_amdgcn_sched_barrier(0)
    Unit cur, nxt; int ui = 0;
    if (!S.next(0, cur)) return;
    f32x4 acc[2][2][4][2];
#pragma unroll
    for (int a = 0; a < 2; ++a)
#pragma unroll
        for (int b = 0; b < 2; ++b)
#pragma unroll
            for (int m = 0; m < 4; ++m)
#pragma unroll
                for (int n = 0; n < 2; ++n) acc[a][b][m][n] = (f32x4){0.f, 0.f, 0.f, 0.f};
    bf16x8 At[4][2], B0[2][2], B1[2][2];
#if G_SP2
    G_STAGE_B(G_SB(0, 0), cur.b, 0u); G_STAGE_B(G_SB(0, 1), cur.b + hstepB, 0u); G_STAGE_A(G_SA(0, 0), cur.a0, cur.a1, 0u); G_STAGE_A(G_SA(0, 1), cur.a2, cur.a3, 0u);
    if (wr == 1) G_BAR;
    G_WAIT_V(2); G_BAR;
#else
    G_STAGE_B(G_SB(0, 0), cur.b, 0u); G_STAGE_A(G_SA(0, 0), cur.a0, cur.a1, 0u); G_STAGE_B(G_SB(0, 1), cur.b + hstepB, 0u); G_STAGE_A(G_SA(0, 1), cur.a2, cur.a3, 0u);
    if (wr == 1) G_BAR;
    G_WAIT_V(4); G_BAR;
#endif
    G_STAGE_B(G_SB(1, 0), cur.b, kstepB); G_STAGE_A(G_SA(1, 0), cur.a0, cur.a1, kstepA); G_STAGE_B(G_SB(1, 1), cur.b + hstepB, kstepB);
    G_WAIT_V(6); G_BAR;
    for (;;) {
        const bool has_next = S.next(ui + 1, nxt);
        const unsigned n0 = has_next ? nxt.a0 : cur.a0, n1 = has_next ? nxt.a1 : cur.a1, n2 = has_next ? nxt.a2 : cur.a2, n3 = has_next ? nxt.a3 : cur.a3;
        const unsigned nB = has_next ? nxt.b : cur.b;
        for (int t = 0; t < nt; t += 2) {
            const bool last = (t == nt - 2);
            const unsigned k1 = (unsigned)(t + 1) * kstepA;
            const unsigned k2 = last ? 0u : (unsigned)(t + 2) * kstepA, k3 = k2 + kstepA;
            const unsigned kb2 = last ? 0u : (unsigned)(t + 2) * kstepB, kb3 = kb2 + kstepB;
            const unsigned x0 = last ? n0 : cur.a0, x1 = last ? n1 : cur.a1, x2 = last ? n2 : cur.a2, x3 = last ? n3 : cur.a3;
            const unsigned xb = last ? nB : cur.b;
#if G_SP2
            G_LDB(B0, 0, 0); G_LDB(B1, 0, 1); G_SCHED; G_LDA(At, 0, 0); G_STAGE_A(G_SA(1, 1), cur.a2, cur.a3, k1);
            G_WAIT_V(8); G_WAIT_L(0); G_BAR; G_MMA(0, 0, At, B0); G_MMA(0, 1, At, B1); G_BAR; G_SCHED;
            G_LDA(At, 0, 1); G_STAGE_B(G_SB(0, 0), xb, kb2); G_STAGE_B(G_SB(0, 1), xb + hstepB, kb2); G_STAGE_A(G_SA(0, 0), x0, x1, k2);
            G_WAIT_V(8); G_WAIT_L(0); G_BAR; G_MMA(1, 0, At, B0); G_MMA(1, 1, At, B1); G_BAR; G_SCHED;
            G_LDB(B0, 1, 0); G_LDB(B1, 1, 1); G_SCHED; G_LDA(At, 1, 0); G_STAGE_A(G_SA(0, 1), x2, x3, k2);
            G_WAIT_V(8); G_WAIT_L(0); G_BAR; G_MMA(0, 0, At, B0); G_MMA(0, 1, At, B1); G_BAR; G_SCHED;
            G_LDA(At, 1, 1); G_STAGE_B(G_SB(1, 0), xb, kb3); G_STAGE_B(G_SB(1, 1), xb + hstepB, kb3); G_STAGE_A(G_SA(1, 0), x0, x1, k3);
            G_WAIT_V(8); G_WAIT_L(0); G_BAR; G_MMA(1, 0, At, B0); G_MMA(1, 1, At, B1); G_BAR; G_SCHED;
#else
            G_LDB(B0, 0, 0); G_SCHED; G_LDA(At, 0, 0); G_STAGE_A(G_SA(1, 1), cur.a2, cur.a3, k1);
            G_WAIT_L(8); G_BAR; G_WAIT_L(0); G_MMA(0, 0, At, B0); G_BAR; G_SCHED;
            G_LDB(B1, 0, 1); G_STAGE_B(G_SB(0, 0), xb, kb2);
            G_BAR; G_WAIT_L(0); G_MMA(0, 1, At, B1); G_BAR;
            G_LDA(At, 0, 1); G_STAGE_A(G_SA(0, 0), x0, x1, k2);
            G_BAR; G_WAIT_L(0); G_MMA(1, 0, At, B0); G_BAR; G_SCHED;
            G_STAGE_B(G_SB(0, 1), xb + hstepB, kb2);
            G_WAIT_V(6); G_BAR; G_MMA(1, 1, At, B1); G_BAR;
            G_LDB(B0, 1, 0); G_SCHED; G_LDA(At, 1, 0); G_STAGE_A(G_SA(0, 1), x2, x3, k2);
            G_WAIT_L(8); G_BAR; G_WAIT_L(0); G_MMA(0, 0, At, B0); G_BAR; G_SCHED;
            G_LDB(B1, 1, 1); G_STAGE_B(G_SB(1, 0), xb, kb3);
            G_BAR; G_WAIT_L(0); G_MMA(0, 1, At, B1); G_BAR;
            G_LDA(At, 1, 1); G_STAGE_A(G_SA(1, 0), x0, x1, k3);
            G_BAR; G_WAIT_L(0); G_MMA(1, 0, At, B0); G_BAR; G_SCHED;
            G_STAGE_B(G_SB(1, 1), xb + hstepB, kb3);
            G_WAIT_V(6); G_BAR; G_MMA(1, 1, At, B1); G_BAR;
        #endif
        }
#if G_ALIGN
        if (wr == 0) G_BAR;
#endif
        E(acc, cur, wr, wc, fr, fq);
        if (!has_next) break;
#pragma unroll
        for (int a = 0; a < 2; ++a)
#pragma unroll
            for (int b = 0; b < 2; ++b)
#pragma unroll
                for (int m = 0; m < 4; ++m)
#pragma unroll
                    for (int n = 0; n < 2; ++n) acc[a][b][m][n] = (f32x4){0.f, 0.f, 0.f, 0.f};
        cur = nxt; ++ui;
#if G_ALIGN
        if (wr == 1) G_BAR;
#endif
    }
    G_WAIT_V(0);
#if !G_ALIGN
    if (wr == 0) G_BAR;
#endif
    G_BAR;
}

DI u32x4 pack8(const f32x4& v0, const f32x4& v1) { u32x4 w; w.x = pk2(v0[0], v0[1]); w.y = pk2(v0[2], v0[3]); w.z = pk2(v1[0], v1[1]); w.w = pk2(v1[2], v1[3]); return w; }

struct EpiPlain {
    bf16_t* C; int ldc;
    DI void operator()(const f32x4 (&acc)[2][2][4][2], const Unit& u, int wr, int wc, int fr, int fq) const {
        const int row0 = u.pm * 256 + wr * 64 + fr, col0 = u.pn * 256 + wc * 32 + 8 * fq;
#pragma unroll
        for (int ai = 0; ai < 2; ++ai)
#pragma unroll
            for (int m = 0; m < 4; ++m) { bf16_t* rowp = C + (size_t)(row0 + ai * 128 + m * 16) * ldc + col0;
#pragma unroll
                for (int bj = 0; bj < 2; ++bj) *(u32x4*)(rowp + bj * 128) = pack8(acc[ai][bj][m][0], acc[ai][bj][m][1]); }
    }
};

struct EpiF32Part {
    float* P;
    DI void operator()(const f32x4 (&acc)[2][2][4][2], const Unit& u, int wr, int wc, int fr, int fq) const {
        const int row0 = u.pm * 256 + wr * 64 + fr, col0 = u.pn * 256 + wc * 32 + 8 * fq;
        float* base = P + (size_t)u.z * MCTX * DM;
#pragma unroll
        for (int ai = 0; ai < 2; ++ai)
#pragma unroll
            for (int m = 0; m < 4; ++m) { float* rowp = base + (size_t)(row0 + ai * 128 + m * 16) * DM + col0;
#pragma unroll
                for (int bj = 0; bj < 2; ++bj) { *(f32x4*)(rowp + bj * 128) = acc[ai][bj][m][0]; *(f32x4*)(rowp + bj * 128 + 4) = acc[ai][bj][m][1]; } }
    }
};

struct EpiQKVF {
    bf16_t *QH, *KH, *VT, *F;
    DI void operator()(const f32x4 (&acc)[2][2][4][2], const Unit& u, int wr, int wc, int fr, int fq) const {
        const int kind = u.pn >> 2, sub = u.pn & 3;
        const int row0 = u.pm * 256 + wr * 64 + fr;
#pragma unroll
        for (int ai = 0; ai < 2; ++ai)
#pragma unroll
            for (int m = 0; m < 4; ++m) {
                const int row = row0 + ai * 128 + m * 16;
#pragma unroll
                for (int bj = 0; bj < 2; ++bj) {
                    const int cl = 128 * bj + 32 * wc + 8 * fq, head = sub * 4 + (cl >> 6), d0 = cl & 63;
                    const u32x4 w = pack8(acc[ai][bj][m][0], acc[ai][bj][m][1]);
                    if (kind == 0) *(u32x4*)(QH + ((size_t)head * MALL + row) * 64 + d0) = w;
                    else if (kind == 1) *(u32x4*)(KH + ((size_t)head * MALL + row) * 64 + d0) = w;
                    else if (kind == 3) *(u32x4*)(F + (size_t)row * 1024 + sub * 256 + cl) = w;
                    else { bf16_t* vp = VT + (size_t)(head * 64 + d0) * MALL + row;
                        vp[0] = (bf16_t)(w.x & 0xffffu); vp[(size_t)MALL] = (bf16_t)(w.x >> 16); vp[(size_t)2 * MALL] = (bf16_t)(w.y & 0xffffu); vp[(size_t)3 * MALL] = (bf16_t)(w.y >> 16);
                        vp[(size_t)4 * MALL] = (bf16_t)(w.z & 0xffffu); vp[(size_t)5 * MALL] = (bf16_t)(w.z >> 16); vp[(size_t)6 * MALL] = (bf16_t)(w.w & 0xffffu); vp[(size_t)7 * MALL] = (bf16_t)(w.w >> 16); }
                }
            }
    }
};

struct EpiGT {
    bf16_t *GT, *GTC; int ctx;
    DI void operator()(const f32x4 (&acc)[2][2][4][2], const Unit& u, int wr, int wc, int fr, int fq) const {
#pragma unroll
        for (int ai = 0; ai < 2; ++ai)
#pragma unroll
            for (int m = 0; m < 4; ++m) {
                const int e = wr * 64 + m * 16 + fr;
#pragma unroll
                for (int bj = 0; bj < 2; ++bj) {
                    const int cl = 128 * bj + 32 * wc + 8 * fq;
                    const u32x4 w = pack8(acc[ai][bj][m][0], acc[ai][bj][m][1]);
                    if (!ctx) { const int b = u.pn >> 4, n0 = (4 * (u.pn & 15) + (cl >> 6)) * 64 + (cl & 63); *(u32x4*)(GT + ((size_t)(b * 1024 + u.z * 128 + e)) * 8192 + ai * 4096 + n0) = w; }
                    else { const int b = u.pn; *(u32x4*)(GTC + ((size_t)(b * 1024 + u.z * 128 + e)) * 512 + ai * 256 + cl) = w; }
                }
            }
    }
};

struct EpiF2 {
    bf16_t* MIXCAT; float scale; int rowbase, rpz;
    DI void operator()(const f32x4 (&acc)[2][2][4][2], const Unit& u, int wr, int wc, int fr, int fq) const {
        const int row0 = rowbase + u.z * rpz + u.pm * 256 + wr * 64 + fr, col0 = 1024 + u.pn * 256 + wc * 32 + 8 * fq;
#pragma unroll
        for (int ai = 0; ai < 2; ++ai)
#pragma unroll
            for (int m = 0; m < 4; ++m) { bf16_t* rowp = MIXCAT + (size_t)(row0 + ai * 128 + m * 16) * DM + col0;
#pragma unroll
                for (int bj = 0; bj < 2; ++bj) *(u32x4*)(rowp + bj * 128) = pack8(acc[ai][bj][m][0] * scale, acc[ai][bj][m][1] * scale); }
    }
};

struct EpiStageA {
    bf16_t* YP; const float* TW;
    DI void operator()(const f32x4 (&acc)[2][2][4][2], const Unit& u, int wr, int wc, int fr, int fq) const {
        if (wr != 0) return;
#pragma unroll
        for (int m = 0; m < 4; ++m) {
            const int k1 = 16 * m + fr;
#pragma unroll
            for (int bj = 0; bj < 2; ++bj) {
                const int j0 = 128 * bj + 32 * wc + 8 * fq, ge = 4 * u.pn + (j0 >> 6), nl0 = j0 & 63;
                const f32x4* tw = (const f32x4*)(TW + (size_t)(k1 * 64 + nl0) * 2);
                f32x4 yr[2], yi[2];
#pragma unroll
                for (int n = 0; n < 2; ++n) {
                    const f32x4 t0 = tw[2 * n], t1 = tw[2 * n + 1];
                    const f32x4 c = {t0.x, t0.z, t1.x, t1.z}, s = {t0.y, t0.w, t1.y, t1.w};
                    const f32x4 r = acc[0][bj][m][n], i = acc[1][bj][m][n];
                    yr[n] = c * r + s * i; yi[n] = c * i - s * r;
                }
                bf16_t* dst = YP + ((((size_t)(u.z * 64 + k1)) * 1024 + ge) * 2) * 64 + nl0;
                *(u32x4*)dst = pack8(yr[0], yr[1]); *(u32x4*)(dst + 64) = pack8(yi[0], yi[1]);
            }
        }
    }
};
struct EpiStageB {
    bf16_t* MIXCAT;
    DI void operator()(const f32x4 (&acc)[2][2][4][2], const Unit& u, int wr, int wc, int fr, int fq) const {
        if (wr != 0) return;
        const int b = u.z >> 6, k1 = u.z & 63;
#pragma unroll
        for (int m = 0; m < 4; ++m) { const int k2 = 16 * m + fr; bf16_t* rowp = MIXCAT + (size_t)(b * 4096 + k1 + 64 * k2) * DM + 1024 + u.pn * 256 + wc * 32 + 8 * fq;
#pragma unroll
            for (int bj = 0; bj < 2; ++bj) *(u32x4*)(rowp + bj * 128) = pack8(acc[0][bj][m][0] * 0.015625f, acc[0][bj][m][1] * 0.015625f); }
    }
};

DI float dpp_ror1(float v) { return __builtin_bit_cast(float, __builtin_amdgcn_update_dpp(0, __builtin_bit_cast(int, v), 0x121, 0xF, 0xF, false)); }
DI float dpp_rol1(float v) { return __builtin_bit_cast(float, __builtin_amdgcn_update_dpp(0, __builtin_bit_cast(int, v), 0x12F, 0xF, 0xF, false)); }

struct EpiUpConv {
    bf16_t* ACT; bf16_t* RAW; const float* cw; const float* cb;
    DI void operator()(const f32x4 (&acc)[2][2][4][2], const Unit& u, int wr, int wc, int fr, int fq) const {
        const int colA = 128 * u.pn + 32 * wc + 8 * fq;
#pragma unroll
        for (int n = 0; n < 2; ++n) {
            const int ca = colA + 4 * n;
            const f32x4 wa0 = *(const f32x4*)(cw + ca), wa1 = *(const f32x4*)(cw + DFF2 + ca), wa2 = *(const f32x4*)(cw + 2 * DFF2 + ca), ba = *(const f32x4*)(cb + ca);
            const f32x4 wg0 = *(const f32x4*)(cw + DFF + ca), wg1 = *(const f32x4*)(cw + DFF2 + DFF + ca), wg2 = *(const f32x4*)(cw + 2 * DFF2 + DFF + ca), bg = *(const f32x4*)(cb + DFF + ca);
#pragma unroll
            for (int ai = 0; ai < 2; ++ai) {
                const int sg = 4 * u.pm + 2 * ai + wr, row0 = 64 * sg;
#pragma unroll
                for (int m = 0; m < 4; ++m) {
                    const int rho = 16 * m + fr;
                    const f32x4 ca_ = acc[ai][0][m][n], cg_ = acc[ai][1][m][n];
                    const f32x4 ua_ = acc[ai][0][m > 0 ? m - 1 : 0][n], ug_ = acc[ai][1][m > 0 ? m - 1 : 0][n];
                    const f32x4 da_ = acc[ai][0][m < 3 ? m + 1 : 3][n], dg_ = acc[ai][1][m < 3 ? m + 1 : 3][n];
                    float o[4];
#pragma unroll
                    for (int j = 0; j < 4; ++j) {
                        const float upa = dpp_ror1(fr == 15 ? ua_[j] : ca_[j]), dna = dpp_rol1(fr == 0 ? da_[j] : ca_[j]);
                        const float upg = dpp_ror1(fr == 15 ? ug_[j] : cg_[j]), dng = dpp_rol1(fr == 0 ? dg_[j] : cg_[j]);
                        const float va = wa0[j] * upa + wa1[j] * ca_[j] + wa2[j] * dna + ba[j];
                        const float vg = wg0[j] * upg + wg1[j] * cg_[j] + wg2[j] * dng + bg[j];
                        const float sgm = vg * __builtin_amdgcn_rcpf(1.f + __builtin_amdgcn_exp2f(-vg * LOG2E));
                        o[j] = sgm * va;
                    }
                    if (rho >= 1 && rho <= 62) { u32x2 w; w.x = pk2(o[0], o[1]); w.y = pk2(o[2], o[3]); *(u32x2*)(ACT + (size_t)(row0 + rho) * DFF + ca) = w; }
                    if (m == 0 || m == 3) {
                        if (rho <= 1 || rho >= 62) { const int slot = rho <= 1 ? rho : rho - 60;
                            bf16_t* rp = RAW + ((size_t)sg * 4 + slot) * DFF2 + ca;
                            u32x2 wa; wa.x = pk2(ca_[0], ca_[1]); wa.y = pk2(ca_[2], ca_[3]); *(u32x2*)rp = wa;
                            u32x2 wg; wg.x = pk2(cg_[0], cg_[1]); wg.y = pk2(cg_[2], cg_[3]); *(u32x2*)(rp + DFF) = wg; }
                    }
                }
            }
        }
    }
};
DI void up_fixup(ArgsRef a, int l) {
    const int tid = tid_opaque(), gtid = blockIdx.x * 512 + tid, NT = gridDim.x * 512;
    const bf16_t* RAW = (const bf16_t*)(a.ws + WS_RAW); bf16_t* ACT = (bf16_t*)(a.ws + WS_ACT);
    const float* cw = a.in[I_CONVW] + (size_t)l * 3 * DFF2; const float* cb = a.in[I_CONVB] + (size_t)l * DFF2;
    const int nstrips = l == 0 ? MALL / 64 : MLAT / 64;
    auto ld4 = [&](const bf16_t* p) -> f32x4 { const u32x2 w = *(const u32x2*)p; return (f32x4){bflo(w.x), bfhi(w.x), bflo(w.y), bfhi(w.y)}; };
    for (int it = gtid; it < nstrips * 2 * (DFF / 4); it += NT) {
        const int c4 = it % (DFF / 4), rw = it / (DFF / 4), sg = rw >> 1, last = rw & 1, ca = 4 * c4;
        const bool first_of_seq = sg < MLAT / 64 ? (sg & 63) == 0 : ((sg - MLAT / 64) & 3) == 0;
        const bool last_of_seq = sg < MLAT / 64 ? (sg & 63) == 63 : ((sg - MLAT / 64) & 3) == 3;
        const bf16_t* cur = RAW + ((size_t)sg * 4 + (last ? 3 : 0)) * DFF2 + ca;
        const bf16_t* up = last ? RAW + ((size_t)sg * 4 + 2) * DFF2 + ca : RAW + ((size_t)(sg - 1) * 4 + 3) * DFF2 + ca;
        const bf16_t* dn = last ? RAW + ((size_t)(sg + 1) * 4 + 0) * DFF2 + ca : RAW + ((size_t)sg * 4 + 1) * DFF2 + ca;
        const bool has_up = last || !first_of_seq, has_dn = !last || !last_of_seq;
        const f32x4 z = {0.f, 0.f, 0.f, 0.f};
        const f32x4 ca_ = ld4(cur), cg_ = ld4(cur + DFF);
        const f32x4 ua_ = has_up ? ld4(up) : z, ug_ = has_up ? ld4(up + DFF) : z;
        const f32x4 da_ = has_dn ? ld4(dn) : z, dg_ = has_dn ? ld4(dn + DFF) : z;
        const f32x4 wa0 = *(const f32x4*)(cw + ca), wa1 = *(const f32x4*)(cw + DFF2 + ca), wa2 = *(const f32x4*)(cw + 2 * DFF2 + ca), ba = *(const f32x4*)(cb + ca);
        const f32x4 wg0 = *(const f32x4*)(cw + DFF + ca), wg1 = *(const f32x4*)(cw + DFF2 + DFF + ca), wg2 = *(const f32x4*)(cw + 2 * DFF2 + DFF + ca), bg = *(const f32x4*)(cb + DFF + ca);
        const f32x4 va = wa0 * ua_ + wa1 * ca_ + wa2 * da_ + ba, vg = wg0 * ug_ + wg1 * cg_ + wg2 * dg_ + bg;
        float o[4];
#pragma unroll
        for (int j = 0; j < 4; ++j) o[j] = vg[j] * __builtin_amdgcn_rcpf(1.f + __builtin_amdgcn_exp2f(-vg[j] * LOG2E)) * va[j];
        u32x2 w; w.x = pk2(o[0], o[1]); w.y = pk2(o[2], o[3]);
        *(u32x2*)(ACT + (size_t)(64 * sg + (last ? 63 : 0)) * DFF + ca) = w;
    }
}

DI float wave_sum(float v) {
#pragma unroll
    for (int o = 1; o < 64; o <<= 1) v += __shfl_xor(v, o);
    return v;
}
#define LDS_WAIT() asm volatile("s_waitcnt lgkmcnt(0)" ::: "memory")

DI void p0_mods_item(LAS unsigned char* lds, ArgsRef a, float* MODS, int item) {
    const int tid = tid_opaque(), l = item / 96, chunk = item - 96 * l;
    LAS float* sc = (LAS float*)lds;
    const float* c = a.in[I_C]; const float* cctx = a.in[I_CCTX];
    for (int i = tid; i < 2048 * 9; i += 512) { const int k = i / 9, b = i - 9 * k; const float v = (b < 8) ? c[b * 2048 + k] : cctx[k]; sc[i] = v / (1.f + __expf(-v)); }
    __syncthreads();
    const int ks = tid >> 5, cgp = tid & 31, col = chunk * 128 + cgp * 4;
    const float* W = a.in[I_WADA] + (size_t)l * 2048 * NMODS + col;
    f32x4 acc[9];
#pragma unroll
    for (int b = 0; b < 9; ++b) acc[b] = (f32x4){0.f, 0.f, 0.f, 0.f};
#pragma unroll 4
    for (int k = ks * 128; k < ks * 128 + 128; ++k) {
        const f32x4 w = *(const f32x4*)(W + (size_t)k * NMODS);
#pragma unroll
        for (int b = 0; b < 9; ++b) acc[b] += sc[k * 9 + b] * w;
    }
    __syncthreads();
    LAS float* red = (LAS float*)lds;
#pragma unroll
    for (int b = 0; b < 9; ++b) *(LAS f32x4*)(red + (ks * 9 + b) * 128 + cgp * 4) = acc[b];
    __syncthreads();
    for (int o = tid; o < 9 * 128; o += 512) { const int b = o >> 7, cc = o & 127; float s = 0.f;
#pragma unroll
        for (int k2 = 0; k2 < 16; ++k2) s += red[(k2 * 9 + b) * 128 + cc];
        MODS[(size_t)(l * 9 + b) * NMODS + chunk * 128 + cc] = s + a.in[I_BADA][l * NMODS + chunk * 128 + cc]; }
    __syncthreads();
}
DI void p0_transpose_item(const float* W, int K, int N, bf16_t* WT, int up_map, LAS float* scr, int item, int lane) {
    const int nblk = N / 32, kb = item / nblk, nb = item - kb * nblk, k0 = 64 * kb, n0 = 32 * nb;
    int rowbase = n0;
    if (up_map) rowbase = (n0 < DFF) ? 256 * (n0 / 128) + (n0 % 128) : 256 * ((n0 - DFF) / 128) + 128 + ((n0 - DFF) % 128);
#pragma unroll 8
    for (int i = 0; i < 32; ++i) { const int kk = 2 * i + (lane >> 5); scr[kk * 33 + (lane & 31)] = W[(size_t)(k0 + kk) * N + n0 + (lane & 31)]; }
    LDS_WAIT(); asm volatile("" ::: "memory");
    const int c = lane & 7;
#pragma unroll
    for (int j = 0; j < 4; ++j) { const int n = (lane >> 3) + 8 * j; const LAS float* s = scr + (8 * c) * 33 + n;
        u32x4 o; o.x = pk2(s[0 * 33], s[1 * 33]); o.y = pk2(s[2 * 33], s[3 * 33]); o.z = pk2(s[4 * 33], s[5 * 33]); o.w = pk2(s[6 * 33], s[7 * 33]);
        *(u32x4*)(WT + (size_t)(rowbase + n) * K + k0 + 8 * c) = o; }
    LDS_WAIT(); asm volatile("" ::: "memory");
}
DI void p0_prologue(LAS unsigned char* lds, ArgsRef a) {
    const int tid = tid_opaque(), lane = tid & 63, wave = tid >> 6, G = gridDim.x, bx = blockIdx.x;
    unsigned char* ws = a.ws;
    __syncthreads();
    for (int item = bx; item < 192; item += G) p0_mods_item(lds, a, (float*)(ws + WS_MODS), item);
    LAS float* tab = (LAS float*)lds;
    __syncthreads();
    for (int p = tid; p < 4096; p += 512) tab[p] = cospif((float)p * (1.f / 2048.f));
    __syncthreads();
    const int gtid = bx * 512 + tid, NT = G * 512;
    {
        bf16_t* MA = (bf16_t*)(ws + WS_MA); bf16_t* MB = (bf16_t*)(ws + WS_MB); float* TW = (float*)(ws + WS_TW);
        for (int i = gtid; i < 256 * 128; i += NT) { const int r = i >> 7, col = i & 127, ri = r >> 7, rr = r & 127, cs = col >> 6, q = col & 63;
            float va = 0.f;
            if (rr < 64) { const int p = (rr * q * 64) & 4095; const float c = tab[p], s = tab[(p - 1024) & 4095]; va = ri == 0 ? (cs == 0 ? c : -s) : (cs == 0 ? -s : -c); }
            MA[i] = (bf16_t)(pk2(va, 0.f) & 0xffffu);
            float vb = 0.f;
            if (r < 64) { const int p = (r * q * 64) & 4095; vb = cs == 0 ? tab[p] : tab[(p - 1024) & 4095]; }
            MB[i] = (bf16_t)(pk2(vb, 0.f) & 0xffffu);
        }
        for (int i = gtid; i < 64 * 64; i += NT) { const int p = ((i >> 6) * (i & 63)) & 4095; TW[2 * i] = tab[p]; TW[2 * i + 1] = tab[(p - 1024) & 4095]; }
        bf16_t* D256 = (bf16_t*)(ws + WS_DFT256);
        for (int ch = gtid; ch < 256 * 64; ch += NT) { const int kp = ch >> 6, j0 = (ch & 63) * 8, cs = j0 >> 8, n0 = j0 & 255;
            float v[8];
#pragma unroll
            for (int e = 0; e < 8; ++e) v[e] = tab[((((kp * (n0 + e)) & 255) << 4) + cs * 1024) & 4095];
            u32x4 o; o.x = pk2(v[0], v[1]); o.y = pk2(v[2], v[3]); o.z = pk2(v[4], v[5]); o.w = pk2(v[6], v[7]);
            *(u32x4*)(D256 + (size_t)ch * 8) = o; }
        bf16_t* WCS = (bf16_t*)(ws + WS_WCS);
        for (int ch = gtid; ch < 65536; ch += NT) { const int c0 = (ch & 15) * 8, r = (ch >> 4) & 255, cs = r >> 7, e = r & 127, lg = ch >> 12;
            const float* wf = a.in[I_WFOUR] + (size_t)lg * 128 * 128 + e;
            float v[8];
#pragma unroll
            for (int q = 0; q < 8; ++q) v[q] = 0.f;
            for (int m = 0; m < 128; ++m) { const float w = wf[m * 128];
#pragma unroll
                for (int q = 0; q < 8; ++q) v[q] += w * tab[((((m * (c0 + q)) & 127) << 5) - cs * 1024) & 4095]; }
            const float sc = 0.08838834764831845f;
            u32x4 o; o.x = pk2(v[0] * sc, v[1] * sc); o.y = pk2(v[2] * sc, v[3] * sc); o.z = pk2(v[4] * sc, v[5] * sc); o.w = pk2(v[6] * sc, v[7] * sc);
            *(u32x4*)(WCS + (size_t)ch * 8) = o; }
        bf16_t* H = (bf16_t*)(ws + WS_H);
        for (int i = gtid; i < 32 * 256; i += NT) { const int rr = i >> 8, cc = (i & 255) * 8, seq = rr >> 1, hi = rr & 1;
            const long prow = seq < 8 ? (long)seq * LPAD + (hi ? LPAD - 1 : 0) : (long)CTXPB0 + (long)(seq - 8) * CPAD + (hi ? CPAD - 1 : 0);
            *(u32x4*)(H + prow * DM + cc) = (u32x4){0u, 0u, 0u, 0u}; }
    }
    __syncthreads();
    LAS float* scr = (LAS float*)(lds + wave * 16384);
    const int gw = bx * 8 + wave, NGW = G * 8;
    for (int it = gw; it < 2 * 23040; it += NGW) {
        const int l = it / 23040; int r = it - l * 23040;
        if (r < 4096) { p0_transpose_item(a.in[I_WIN] + (size_t)l * 2048 * 4096, 2048, 4096, (bf16_t*)(ws + WS_WIN) + (size_t)l * 4096 * 2048, 0, scr, r, lane); continue; } r -= 4096;
        if (r < 2048) { p0_transpose_item(a.in[I_WOUT] + (size_t)l * 2048 * 2048, 2048, 2048, (bf16_t*)(ws + WS_WOUT) + (size_t)l * 2048 * 2048, 0, scr, r, lane); continue; } r -= 2048;
        if (r < 11264) { p0_transpose_item(a.in[I_WUP] + (size_t)l * 2048 * DFF2, 2048, DFF2, (bf16_t*)(ws + WS_WUP) + (size_t)l * DFF2 * 2048, 1, scr, r, lane); continue; } r -= 11264;
        p0_transpose_item(a.in[I_WDOWN] + (size_t)l * DFF * 2048, DFF, 2048, (bf16_t*)(ws + WS_WDN) + (size_t)l * 2048 * DFF, 0, scr, r, lane);
    }
}

struct Row32 { f32x4 v[8]; };
DI void ld_row_f32(Row32& r, const float* p, int lane) {
#pragma unroll
    for (int j = 0; j < 4; ++j) { const f32x4* q = (const f32x4*)(p + j * 512 + lane * 8); r.v[2 * j] = q[0]; r.v[2 * j + 1] = q[1]; }
}
DI void st_row_f32(const Row32& r, float* p, int lane) {
#pragma unroll
    for (int j = 0; j < 4; ++j) { f32x4* q = (f32x4*)(p + j * 512 + lane * 8); q[0] = r.v[2 * j]; q[1] = r.v[2 * j + 1]; }
}
DI void ld_row_bf16(Row32& r, const bf16_t* p, int lane) {
#pragma unroll
    for (int j = 0; j < 4; ++j) { const u32x4 w = *(const u32x4*)(p + j * 512 + lane * 8);
        r.v[2 * j] = (f32x4){bflo(w.x), bfhi(w.x), bflo(w.y), bfhi(w.y)}; r.v[2 * j + 1] = (f32x4){bflo(w.z), bfhi(w.z), bflo(w.w), bfhi(w.w)}; }
}
DI void ld_row_part4(Row32& r, const float* p, int lane) {
    Row32 t; ld_row_f32(r, p, lane);
#pragma unroll
    for (int z = 1; z < 4; ++z) { ld_row_f32(t, p + (size_t)z * MCTX * DM, lane);
#pragma unroll
        for (int i = 0; i < 8; ++i) r.v[i] += t.v[i]; }
}
DI void st_row_bf16(const Row32& r, bf16_t* p, int lane) {
#pragma unroll
    for (int j = 0; j < 4; ++j) *(u32x4*)(p + j * 512 + lane * 8) = pack8(r.v[2 * j], r.v[2 * j + 1]);
}
DI float row_rms_scale(const Row32& r) {
    float s = 0.f;
#pragma unroll
    for (int i = 0; i < 8; ++i) s += (r.v[i].x * r.v[i].x + r.v[i].y * r.v[i].y) + (r.v[i].z * r.v[i].z + r.v[i].w * r.v[i].w);
    s = wave_sum(s);
    return 1.0f / sqrtf(s * (1.f / DM) + EPS);
}
DI void norm_mod_store(const Row32& x, float rs, const float* g, const float* shift, const float* scale, bf16_t* dst, int lane) {
    Row32 gg, sh, sc, o; ld_row_f32(gg, g, lane); ld_row_f32(sh, shift, lane); ld_row_f32(sc, scale, lane);
#pragma unroll
    for (int i = 0; i < 8; ++i) o.v[i] = (x.v[i] * rs * gg.v[i]) * (1.f + sc.v[i]) + sh.v[i];
    st_row_bf16(o, dst, lane);
}
DI int row_mod_idx(int g) { return g < MLAT ? (g >> 12) : 8; }

DI void ew_h0(ArgsRef a) {
    const int tid = tid_opaque(), lane = tid & 63, gw = blockIdx.x * 8 + (tid >> 6), NGW = gridDim.x * 8;
    const float* MODS = (const float*)(a.ws + WS_MODS); bf16_t* H = (bf16_t*)(a.ws + WS_H);
    for (int g = gw; g < MALL; g += NGW) {
        const float* xr = g < MLAT ? a.in[I_X] + (size_t)g * DM : a.in[I_CTX] + (size_t)(g - MLAT) * DM;
        Row32 x; ld_row_f32(x, xr, lane);
        const float rs = row_rms_scale(x);
        const float* md = MODS + (size_t)row_mod_idx(g) * NMODS;
        norm_mod_store(x, rs, a.in[I_GPREMIX], md + 0 * DM, md + 1 * DM, H + hpad_row(g) * DM, lane);
    }
}
DI void ew1(ArgsRef a, int l) {
    const int tid = tid_opaque(), lane = tid & 63, gw = blockIdx.x * 8 + (tid >> 6), NGW = gridDim.x * 8;
    const float* MODS = (const float*)(a.ws + WS_MODS) + (size_t)l * 9 * NMODS; bf16_t* H = (bf16_t*)(a.ws + WS_H);
    const bf16_t* MIX = (const bf16_t*)(a.ws + WS_MIX); float* CX = (float*)(a.ws + WS_CX);
    const int nrows = l == 0 ? MALL : MLAT;
    auto xin = [&](int g) -> const float* { return g < MLAT ? (l == 0 ? a.in[I_X] + (size_t)g * DM : a.out + (size_t)g * DM) : a.in[I_CTX] + (size_t)(g - MLAT) * DM; };
    auto load = [&](int g, Row32& mx, Row32& x) {
        if (g < MLAT) ld_row_bf16(mx, MIX + (size_t)g * DM, lane); else ld_row_part4(mx, (const float*)(a.ws + WS_PART) + (size_t)(g - MLAT) * DM, lane);
        if (l == 0) ld_row_f32(x, xin(g), lane); else ld_row_bf16(x, (const bf16_t*)xin(g), lane); };
    auto finish = [&](int g, Row32& mx, Row32& x) {
        float* xo = g < MLAT ? a.out + (size_t)g * DM : CX + (size_t)(g - MLAT) * DM;
        const float* md = MODS + (size_t)row_mod_idx(g) * NMODS;
        Row32 t;
        const float r1 = row_rms_scale(mx);
        ld_row_f32(t, a.in[I_GPOSTMIX] + l * DM, lane);
#pragma unroll
        for (int i = 0; i < 8; ++i) mx.v[i] = mx.v[i] * r1 * t.v[i];
        ld_row_f32(t, md + 2 * DM, lane);
#pragma unroll
        for (int i = 0; i < 8; ++i) x.v[i] = x.v[i] + t.v[i] * mx.v[i];
        st_row_bf16(x, (bf16_t*)xo, lane);
        const float r2 = row_rms_scale(x);
        norm_mod_store(x, r2, a.in[I_GPREFFN] + l * DM, md + 3 * DM, md + 4 * DM, H + hpad_row(g) * DM, lane); };
    for (int g = gw; g < nrows; g += 2 * NGW) {
        const int g2 = g + NGW; const bool has2 = g2 < nrows;
        Row32 mxA, xA, mxB, xB;
        load(g, mxA, xA);
        if (has2) load(g2, mxB, xB);
        finish(g, mxA, xA);
        if (has2) finish(g2, mxB, xB);
    }
}
DI void ew2(ArgsRef a, int l) {
    const int tid = tid_opaque(), lane = tid & 63, gw = blockIdx.x * 8 + (tid >> 6), NGW = gridDim.x * 8;
    const float* MODS = (const float*)(a.ws + WS_MODS) + (size_t)l * 9 * NMODS; bf16_t* H = (bf16_t*)(a.ws + WS_H);
    const bf16_t* Y = (const bf16_t*)(a.ws + WS_Y); float* CX = (float*)(a.ws + WS_CX);
    const int nrows = l == 0 ? MALL : MLAT;
    auto xrow = [&](int g) -> float* { return g < MLAT ? a.out + (size_t)g * DM : CX + (size_t)(g - MLAT) * DM; };
    auto load = [&](int g, Row32& y, Row32& x) {
        if (g < MLAT) ld_row_bf16(y, Y + (size_t)g * DM, lane); else ld_row_part4(y, (const float*)(a.ws + WS_PART) + (size_t)(g - MLAT) * DM, lane);
        ld_row_bf16(x, (const bf16_t*)xrow(g), lane); };
    auto finish = [&](int g, Row32& y, Row32& x) {
        float* xo = xrow(g);
        const float* md = MODS + (size_t)row_mod_idx(g) * NMODS;
        Row32 t;
        const float r1 = row_rms_scale(y);
        ld_row_f32(t, a.in[I_GPOSTFFN] + l * DM, lane);
#pragma unroll
        for (int i = 0; i < 8; ++i) y.v[i] = y.v[i] * r1 * t.v[i];
        ld_row_f32(t, md + 5 * DM, lane);
#pragma unroll
        for (int i = 0; i < 8; ++i) x.v[i] = x.v[i] + t.v[i] * y.v[i];
        if (l == 0) st_row_bf16(x, (bf16_t*)xo, lane); else st_row_f32(x, xo, lane);
        if (l == 0) {
            const float r2 = row_rms_scale(x);
            const float* md1 = md + (size_t)9 * NMODS;
            norm_mod_store(x, r2, a.in[I_GPREMIX] + DM, md1 + 0 * DM, md1 + 1 * DM, H + hpad_row(g) * DM, lane);
        } };
    for (int g = gw; g < nrows; g += 2 * NGW) {
        const int g2 = g + NGW; const bool has2 = g2 < nrows;
        Row32 yA, xA, yB, xB;
        load(g, yA, xA);
        if (has2) load(g2, yB, xB);
        finish(g, yA, xA);
        if (has2) finish(g2, yB, xB);
    }
}

#define MFMA32(a, b, c) __builtin_amdgcn_mfma_f32_32x32x16_bf16((a), (b), (c), 0, 0, 0)
DI void attn_phase(LAS unsigned char* lds, ArgsRef a, int l, int vcu, int G) {
    const int tid = tid_opaque(), lane = tid & 63, wid = __builtin_amdgcn_readfirstlane(tid >> 6), li = lane & 31, hg = lane >> 5;
    const bf16_t* QH = (const bf16_t*)(a.ws + WS_QH); const bf16_t* KH = (const bf16_t*)(a.ws + WS_KH); const bf16_t* VT = (const bf16_t*)(a.ws + WS_VT);
    bf16_t* MIXCAT = (bf16_t*)(a.ws + WS_MIXCAT);
    LAS float* tab = (LAS float*)lds;
    __syncthreads();
    { const float* rp = a.in[I_RPB] + (size_t)l * 16 * 465; for (int i = tid; i < 16 * 465; i += 512) tab[i] = rp[i] * LOG2E; }
    __syncthreads();
    const int NLAT = 8192, nitems = NLAT + (l == 0 ? 1024 : 0);
    const float SC = 0.125f * LOG2E;
    const int pil = (li & 0x13) | ((li & 4) << 1) | ((li & 8) >> 1);
    constexpr int KL_OFF = 32768, KL_PITCH = 144, VL_OFF = KL_OFF + 256 * KL_PITCH, VL_PITCH = 528;
    static_assert(VL_OFF + 64 * VL_PITCH <= 131072, "attention LDS map");
    for (int bi = vcu; bi * 8 < nitems; bi += G) {
        const int item = bi * 8 + wid;
        const bool isctx = item >= NLAT;
        int b, h, row = 0, gq0;
        if (!isctx) { row = item & 63; h = (item >> 6) & 15; b = item >> 10; gq0 = b * TL + row * 64 + li; }
        else { const int it = item - NLAT, qb = it & 7; h = (it >> 3) & 15; b = it >> 7; gq0 = MLAT + b * TCX + qb * 32 + li; }
        __syncthreads();
        {
            const char* ksrc = (const char*)(KH + ((size_t)h * MALL + MLAT + b * TCX) * 64);
            const char* vsrc = (const char*)(VT + (size_t)(h * 64) * MALL + MLAT + b * TCX);
            u32x4 kv[4], vv[4];
#pragma unroll
            for (int i = 0; i < 4; ++i) { const int q = tid + 512 * i; kv[i] = *(const u32x4*)(ksrc + (size_t)q * 16); vv[i] = *(const u32x4*)(vsrc + (size_t)(q >> 5) * MALL * 2 + (q & 31) * 16); }
#pragma unroll
            for (int i = 0; i < 4; ++i) { const int q = tid + 512 * i;
                *(LAS u32x4*)(lds + KL_OFF + (q >> 3) * KL_PITCH + (q & 7) * 16) = kv[i];
                *(LAS u32x4*)(lds + VL_OFF + (q >> 5) * VL_PITCH + (q & 31) * 16) = vv[i]; }
        }
        __syncthreads();
        const int rs = row - 4 < 0 ? 0 : (row - 4 > 56 ? 56 : row - 4);
        bf16x8 qfA[4], qfB[4];
        { const bf16x8* qp = (const bf16x8*)(QH + ((size_t)h * MALL + gq0) * 64 + hg * 32);
#pragma unroll
          for (int c = 0; c < 4; ++c) { qfA[c] = qp[c]; qfB[c] = isctx ? qp[c] : qp[c + 32 * 8]; } }
        f32x16 oA0, oA1, oB0, oB1;
#pragma unroll
        for (int i = 0; i < 16; ++i) { oA0[i] = 0.f; oA1[i] = 0.f; oB0[i] = 0.f; oB1[i] = 0.f; }
        float mA = -1e30f, lA = 0.f, mB = -1e30f, lB = 0.f;
        const int ntiles = isctx ? 8 : 24;
        for (int t = 0; t < ntiles; ++t) {
            const bool loc = t >= 8;
            int gk0, kr = 0, cb = 0;
            if (!loc) gk0 = MLAT + b * TCX + 32 * t;
            else { const int tt = t - 8; kr = rs + (tt >> 1); cb = tt & 1; gk0 = b * TL + kr * 64 + 32 * cb; }
            bf16x8 kf[4], vf[2][2];
            if (!loc) {
                const LAS bf16x8* kp = (const LAS bf16x8*)(lds + KL_OFF + (32 * t + pil) * KL_PITCH + hg * 64);
#pragma unroll
                for (int c = 0; c < 4; ++c) kf[c] = kp[c];
#pragma unroll
                for (int db = 0; db < 2; ++db)
#pragma unroll
                    for (int j = 0; j < 2; ++j) vf[db][j] = *(const LAS bf16x8*)(lds + VL_OFF + (db * 32 + li) * VL_PITCH + (32 * t + 16 * j + 8 * hg) * 2);
            } else {
                const bf16x8* kp = (const bf16x8*)(KH + ((size_t)h * MALL + gk0 + pil) * 64 + hg * 32);
#pragma unroll
                for (int c = 0; c < 4; ++c) kf[c] = kp[c];
#pragma unroll
                for (int db = 0; db < 2; ++db)
#pragma unroll
                    for (int j = 0; j < 2; ++j) vf[db][j] = *(const bf16x8*)(VT + (size_t)(h * 64 + db * 32 + li) * MALL + gk0 + 16 * j + 8 * hg);
            }
            auto half_body = [&](auto HC, const bf16x8 (&qf)[4], f32x16& o0, f32x16& o1, float& mrun, float& lrun) {
                constexpr int HALF = decltype(HC)::value;
                const int qcol = 32 * HALF + li;
                const int cs = qcol - 8 < 0 ? 0 : (qcol - 8 > 48 ? 48 : qcol - 8);
                f32x16 s;
#pragma unroll
                for (int i = 0; i < 16; ++i) s[i] = 0.f;
#pragma unroll
                for (int c = 0; c < 4; ++c) s = MFMA32(kf[c], qf[c], s);
                float mx = -1e30f;
                if (loc) {
                    const int tb = (h * 15 + (kr - row) + 7) * 31 + 15 - qcol + 32 * cb + 8 * hg;
                    const int kc0 = 32 * cb + 8 * hg;
#pragma unroll
                    for (int r = 0; r < 4; ++r)
#pragma unroll
                        for (int i = 0; i < 4; ++i) {
                            const int kt = 16 * (r >> 1) + 4 * (r & 1) + i, kc = kc0 + kt;
                            const bool valid = (kc >= cs) && (kc < cs + 16);
                            const float bias = tab[valid ? tb + kt : 0];
                            const float v = valid ? s[4 * r + i] * SC + bias : -1e30f;
                            s[4 * r + i] = v; mx = fmaxf(mx, v);
                        }
                } else {
#pragma unroll
                    for (int i = 0; i < 16; ++i) { const float v = s[i] * SC; s[i] = v; mx = fmaxf(mx, v); }
                }
                mx = fmaxf(mx, __shfl_xor(mx, 32));
                const float mnew = fmaxf(mrun, mx), alpha = __builtin_amdgcn_exp2f(mrun - mnew);
                mrun = mnew;
                if (__builtin_amdgcn_ballot_w64(alpha != 1.0f) != 0ull) {
#pragma unroll
                    for (int i = 0; i < 16; ++i) { o0[i] *= alpha; o1[i] *= alpha; }
                }
                auto pv_chunk = [&](auto JC) { constexpr int J = decltype(JC)::value;
                    float ps = 0.f;
#pragma unroll
                    for (int i = 0; i < 8; ++i) { const float p = __builtin_amdgcn_exp2f(s[8 * J + i] - mnew); s[8 * J + i] = p; ps += p; }
                    u32x4 pw; pw.x = pk2(s[8 * J + 0], s[8 * J + 1]); pw.y = pk2(s[8 * J + 2], s[8 * J + 3]); pw.z = pk2(s[8 * J + 4], s[8 * J + 5]); pw.w = pk2(s[8 * J + 6], s[8 * J + 7]);
                    const bf16x8 pf = __builtin_bit_cast(bf16x8, pw);
                    o0 = MFMA32(vf[0][J], pf, o0);
                    o1 = MFMA32(vf[1][J], pf, o1);
                    return ps; };
                float ps;
                if (!loc || cb == HALF) { ps = pv_chunk(std::integral_constant<int, 0>{}); ps += pv_chunk(std::integral_constant<int, 1>{}); }
                else ps = pv_chunk(std::integral_constant<int, HALF>{});
                lrun = lrun * alpha + ps;
            };
            half_body(std::integral_constant<int, 0>{}, qfA, oA0, oA1, mA, lA);
            if (!isctx) half_body(std::integral_constant<int, 1>{}, qfB, oB0, oB1, mB, lB);
        }
        auto store_half = [&](int gq, const f32x16& o0, const f32x16& o1, float lrun) {
            const float ltot = lrun + __shfl_xor(lrun, 32), inv = 1.f / ltot;
            bf16_t* op = MIXCAT + (size_t)gq * DM + h * 64 + 4 * hg;
#pragma unroll
            for (int r = 0; r < 4; ++r) {
                u32x2 w0; w0.x = pk2(o0[4 * r] * inv, o0[4 * r + 1] * inv); w0.y = pk2(o0[4 * r + 2] * inv, o0[4 * r + 3] * inv);
                u32x2 w1; w1.x = pk2(o1[4 * r] * inv, o1[4 * r + 1] * inv); w1.y = pk2(o1[4 * r + 2] * inv, o1[4 * r + 3] * inv);
                *(u32x2*)(op + 8 * r) = w0; *(u32x2*)(op + 32 + 8 * r) = w1;
            } };
        store_half(gq0, oA0, oA1, lA);
        if (!isctx) store_half(gq0 + 32, oB0, oB1, lB);
    }
}

#define XB_TMO      128
#define XB_XCNT(j)  (256  + 64 * (j))
#define XB_XSUB(j)  (1280 + 64 * (j))
#define XB_XGEN(j)  (2304 + 64 * (j))
#define XB_TOP      3328
#define XB_TOPGEN   3392
#define XCD_BAR_WORDS 3456
#define XB_SPIN_CAP (1u << 18)

__device__ __forceinline__ unsigned xb_ld(unsigned* p)              { return __hip_atomic_load(p, __ATOMIC_RELAXED, __HIP_MEMORY_SCOPE_AGENT); }
__device__ __forceinline__ unsigned xb_add(unsigned* p, unsigned v) { return __hip_atomic_fetch_add(p, v, __ATOMIC_RELAXED, __HIP_MEMORY_SCOPE_AGENT); }
__device__ __forceinline__ unsigned xb_xcc_id() { return (unsigned)__builtin_amdgcn_s_getreg((3 << 11) | 20) & 0xFu; }
#define XB_SPIN(cond, bar) do { unsigned _sp = 0; while (cond) { __builtin_amdgcn_s_sleep(1); \
    if ((++_sp & 255u) == 0u) { if (xb_ld(&(bar)[XB_TMO])) break; if (_sp > XB_SPIN_CAP) { atomicAdd(&(bar)[XB_TMO], 1u); break; } } } } while (0)

struct XcdBarrier {
    unsigned* bar; unsigned x;
    volatile LAS unsigned* st;
};

__device__ __forceinline__ XcdBarrier xcd_barrier_post(unsigned* bar, volatile LAS unsigned* st) {
    XcdBarrier b; b.bar = bar; b.x = xb_xcc_id(); b.st = st;
    if (threadIdx.x == 0) (void)xb_add(&bar[XB_XCNT(b.x)], 1u);
    return b;
}
__device__ __forceinline__ void xcd_barrier_complete(unsigned* bar, unsigned x, unsigned& nloc, unsigned& nx) {
    const unsigned G = gridDim.x * gridDim.y * gridDim.z;
    unsigned sum, cnt, mine, sp = 0u;
    for (;;) {
        sum = 0u; cnt = 0u; mine = 0u;
#pragma unroll
        for (unsigned j = 0; j < 16; ++j) { const unsigned c = xb_ld(&bar[XB_XCNT(j)]); sum += c; cnt += (c > 0u) ? 1u : 0u; mine = (j == x) ? c : mine; }
        if (sum == G) break;
        __builtin_amdgcn_s_sleep(1);
        if ((++sp & 255u) == 0u) { if (xb_ld(&bar[XB_TMO])) break; if (sp > XB_SPIN_CAP) { atomicAdd(&bar[XB_TMO], 1u); break; } }
    }
    nloc = mine > 0u ? mine : 1u; nx = cnt > 0u ? cnt : 1u;
}

__device__ __forceinline__ void xcd_barrier(const XcdBarrier& b) {
    asm volatile("s_waitcnt vmcnt(0)" ::: "memory");
    __syncthreads();
    if (threadIdx.x == 0) {
        unsigned* bar = b.bar;
        __builtin_amdgcn_s_waitcnt(0);
        unsigned nloc = b.st[0], nx = b.st[1];
        if (nloc == 0u) { xcd_barrier_complete(bar, b.x, nloc, nx); b.st[0] = nloc; b.st[1] = nx; }
        const unsigned old = xb_add(&bar[XB_XSUB(b.x)], 1u);
        const unsigned gen = old / nloc;
        if (old + 1u == (gen + 1u) * nloc) {
            __builtin_amdgcn_fence(__ATOMIC_RELEASE, "agent");
            asm volatile("s_waitcnt vmcnt(0)" ::: "memory");
            const unsigned og = xb_add(&bar[XB_TOP], 1u);
            const unsigned tg = og / nx;
            if (og + 1u == (tg + 1u) * nx) xb_add(&bar[XB_TOPGEN], 1u);
            else XB_SPIN(xb_ld(&bar[XB_TOPGEN]) == tg, bar);
            __builtin_amdgcn_fence(__ATOMIC_ACQUIRE, "agent");
            xb_add(&bar[XB_XGEN(b.x)], 1u);
            asm volatile("s_waitcnt vmcnt(0)" ::: "memory");
        } else {
            XB_SPIN(xb_ld(&bar[XB_XGEN(b.x)]) == gen, bar);
            __builtin_amdgcn_fence(__ATOMIC_ACQUIRE, "agent");
            asm volatile("s_waitcnt vmcnt(0)" ::: "memory");
        }
    }
    __syncthreads();
}

__global__ void __launch_bounds__(512, 2) mega_fwd(Args args_by_value) {
    extern __shared__ __attribute__((aligned(16))) unsigned char lds_raw[];
    LAS unsigned char* lds = (LAS unsigned char*)lds_raw;
    const int G = gridDim.x, bx = blockIdx.x;
    const int vcu = (G % 8 == 0) ? (bx % 8) * (G / 8) + bx / 8 : bx;
    const int ph_lo = args_by_value.ph_lo, ph_hi = args_by_value.ph_hi;
    const bool one_launch = (ph_hi - ph_lo) > 1;
    if (one_launch) {
        if (threadIdx.x < 2) ((volatile LAS unsigned*)(lds + LDS_MISC))[threadIdx.x] = 0u;
        __syncthreads();
        (void)xcd_barrier_post((unsigned*)(args_by_value.ws + WS_BAR), (volatile LAS unsigned*)(lds + LDS_MISC));
    }
    for (int ph = ph_lo; ph < ph_hi; ++ph) {
        const CAS Args* ap = (const CAS Args*)__builtin_amdgcn_kernarg_segment_ptr();
        asm volatile("" : "+s"(ap));
        ArgsRef args = *ap;
        unsigned char* ws = args.ws;
        for (int rep = 0; rep <= ((PROBE_DUP >> ph) & 1); ++rep) {
        if (ph == 0) p0_prologue(lds, args);
        else if (ph == 1) ew_h0(args);
        else {
            const int l = (ph - 2) / 10, sub = (ph - 2) - 10 * l;
            const int nMrows = (l == 0) ? MALL / 256 : MLAT / 256;
            Sched S; S.base = (const char*)ws; S.G = G; S.c = bx; S.sAz = 0; S.sBz = 0; S.nZ = 1; S.kstepA = 128; S.kstepB = 128; S.bmode = 0;
            if (sub == 0) {
                S.A = (unsigned)WS_H; S.B = (unsigned)(WS_WIN + (size_t)l * 4096 * 2048 * 2); S.lda2 = DM * 2; S.ldb2 = DM * 2; S.nM = MALL / 256; S.nN = 16; S.mode = 1;
                EpiQKVF E{(bf16_t*)(ws + WS_QH), (bf16_t*)(ws + WS_KH), (bf16_t*)(ws + WS_VT), (bf16_t*)(ws + WS_F)};
                gemm_phase(lds, S, E, DM);
            } else if (sub == 1) {
                S.A = (unsigned)(WS_WCS + (size_t)l * 8 * 256 * 128 * 2); S.sAz = 256 * 128 * 2; S.B = (unsigned)WS_F; S.sBz = 128 * 2; S.lda2 = 128 * 2; S.ldb2 = 1024 * 2;
                S.nM = 1; S.nZ = 8; S.mode = 0;
                const int npass = (l == 0) ? 2 : 1;
                for (int pass = 0; pass < npass; ++pass) {
                    EpiGT E{(bf16_t*)(ws + WS_GT), (bf16_t*)(ws + WS_GTC), pass};
                    if (pass == 0) { S.nN = 128; S.bmode = 1; } else { S.nN = 8; S.bmode = 0; S.B = (unsigned)(WS_F + (size_t)MLAT * 1024 * 2); }
                    gemm_phase(lds, S, E, 128);
                }
                attn_phase(lds, args, l, vcu, G);
            } else if (sub == 2) {
                {
                    S.A = (unsigned)WS_MA; S.sAz = 0; S.lda2 = 128 * 2; S.kstepA = 128; S.B = (unsigned)WS_GT; S.sBz = 1024u * 8192u * 2u; S.ldb2 = 0; S.kstepB = 8192; S.bmode = 2;
                    S.nM = 1; S.nN = 256; S.nZ = 8; S.mode = 0;
                    EpiStageA E{(bf16_t*)(ws + WS_YP), (const float*)(ws + WS_TW)};
                    gemm_phase(lds, S, E, 128);
                }
                if (l == 0) {
                    EpiF2 E; E.MIXCAT = (bf16_t*)(ws + WS_MIXCAT); E.scale = 0.0625f; E.rowbase = MLAT; E.rpz = TCX;
                    S.A = (unsigned)WS_DFT256; S.B = (unsigned)WS_GTC; S.sAz = 0; S.sBz = 1024u * 512u * 2u; S.lda2 = 512 * 2; S.ldb2 = 512 * 2; S.kstepA = 128; S.kstepB = 128; S.bmode = 0;
                    S.nM = 1; S.nN = 4; S.nZ = 8; S.mode = 0;
                    gemm_phase(lds, S, E, 512);
                }
            } else if (sub == 3) {
                S.A = (unsigned)WS_MB; S.sAz = 0; S.lda2 = 128 * 2; S.B = (unsigned)WS_YP; S.sBz = 1024u * 128u * 2u; S.ldb2 = 128 * 2;
                S.nM = 1; S.nN = 4; S.nZ = 512; S.mode = 0;
                EpiStageB E{(bf16_t*)(ws + WS_MIXCAT)};
                gemm_phase(lds, S, E, 128);
            } else if (sub == 4 || sub == 8) {
                EpiPlain E; E.ldc = DM; int K;
                if (sub == 4) { S.A = (unsigned)WS_MIXCAT; S.B = (unsigned)(WS_WOUT + (size_t)l * 2048 * 2048 * 2); S.lda2 = DM * 2; S.ldb2 = DM * 2; K = DM; E.C = (bf16_t*)(ws + WS_MIX); }
                else { S.A = (unsigned)WS_ACT; S.B = (unsigned)(WS_WDN + (size_t)l * 2048 * DFF * 2); S.lda2 = DFF * 2; S.ldb2 = DFF * 2; K = DFF; E.C = (bf16_t*)(ws + WS_Y); }
                S.nM = MLAT / 256; S.nN = 8; S.mode = 0;
                gemm_phase(lds, S, E, K);
                if (l == 0) {
                    EpiF32Part EP{(float*)(ws + WS_PART)};
                    S.A += (unsigned)((size_t)MLAT * S.lda2); S.nM = MCTX / 256; S.nZ = 4; S.sAz = (unsigned)(K / 4) * 2u; S.sBz = (unsigned)(K / 4) * 2u;
                    gemm_phase(lds, S, EP, K / 4);
                }
            } else if (sub == 5) ew1(args, l);
            else if (sub == 6) {
                S.A = (unsigned)WS_H; S.B = (unsigned)(WS_WUP + (size_t)l * DFF2 * 2048 * 2); S.lda2 = DM * 2; S.ldb2 = DM * 2; S.nM = nMrows; S.nN = 44; S.mode = 1;
                EpiUpConv E{(bf16_t*)(ws + WS_ACT), (bf16_t*)(ws + WS_RAW), args.in[I_CONVW] + (size_t)l * 3 * DFF2, args.in[I_CONVB] + (size_t)l * DFF2};
                gemm_phase(lds, S, E, DM);
            } else if (sub == 7) { up_fixup(args, l);
            } else ew2(args, l);
        }
        }
        if (ph + 1 < ph_hi) {
            if (ph_hi == 0x7fffffff) cg::this_grid().sync();
            { XcdBarrier xb; xb.bar = (unsigned*)(ws + WS_BAR); xb.x = xb_xcc_id(); xb.st = (volatile LAS unsigned*)(lds + LDS_MISC); xcd_barrier(xb); }
        }
#ifdef PROBE_SYNC
        if (ph == 1) for (int q = 0; q < PROBE_SYNC; ++q) cg::this_grid().sync();
#endif
    }
}

extern "C" void kernel_launch(void* const* d_in, const int* in_sizes, int n_in, void* d_out, int out_size, void* d_ws, size_t ws_size, hipStream_t stream) {
    static int grid = 0;
    if (grid == 0) {
        int dev = 0, cus = 0, per_cu = 0;
        if (n_in != 18 || ws_size < WS_END) { fprintf(stderr, "kernel_launch: unexpected n_in %d / ws %zu\n", n_in, ws_size); grid = -1; return; }
        (void)hipGetDevice(&dev); (void)hipDeviceGetAttribute(&cus, hipDeviceAttributeMultiprocessorCount, dev);
        if (hipFuncSetAttribute((const void*)mega_fwd, hipFuncAttributeMaxDynamicSharedMemorySize, LDS_BYTES) != hipSuccess) { fprintf(stderr, "kernel_launch: hipFuncSetAttribute failed\n"); grid = -1; return; }
        if (hipOccupancyMaxActiveBlocksPerMultiprocessor(&per_cu, (const void*)mega_fwd, 512, LDS_BYTES) != hipSuccess || per_cu < 1) per_cu = 1;
        (void)hipGetLastError();
        grid = cus * per_cu;
    }
    if (grid < 0) return;
    Args a{};
    for (int i = 0; i < 18; ++i) a.in[i] = (const float*)d_in[i];
    a.out = (float*)d_out; a.ws = (unsigned char*)d_ws;
#if MK_MULTI
    for (int ph = 0; ph < NPH; ++ph) { a.ph_lo = ph; a.ph_hi = ph + 1; hipLaunchKernelGGL(mega_fwd, dim3(grid), dim3(512), LDS_BYTES, stream, a); }
#else
    a.ph_lo = 0; a.ph_hi = NPH;
    if (hipMemsetAsync((char*)d_ws + WS_BAR, 0, XCD_BAR_WORDS * 4, stream) != hipSuccess) { fprintf(stderr, "kernel_launch: memset of barrier words failed\n"); return; }
    void* params[] = {&a};
    hipError_t e = hipLaunchCooperativeKernel((const void*)mega_fwd, dim3(grid), dim3(512), params, LDS_BYTES, stream);
    if (e != hipSuccess) fprintf(stderr, "cooperative launch failed: %s (grid %d)\n", hipGetErrorString(e), grid);
#endif
}
```
